# Optimizing an MI355X kernel written in HIP

```python
import jax, jax.numpy as jnp
from jax import lax
import numpy as np

D_MODEL = 1024
BATCH = 2
SEQ = 8192
DEPTH = 1

CHUNK = 64
POOL_WIDTH = D_MODEL // 2
POOL_WINDOWS = (2, 4, 8, 16)
N_POOL_GROUPS = len(POOL_WINDOWS)
POOL_GROUP = POOL_WIDTH // N_POOL_GROUPS
SB_WIDTH = D_MODEL - POOL_WIDTH
SB_HEAD_DIM = 64
SB_HEADS = SB_WIDTH // SB_HEAD_DIM
Q_BLOCK = 128
D_FF = 4 * D_MODEL
PLE_DIM = 256
IN_WIDTH = POOL_WIDTH + 3 * SB_WIDTH
EPS = 1e-6

kernel_name = "hybrid_pool_stickbreaking_block"


def rms_norm(x, g):
    xf = x.astype(jnp.float32)
    y = xf * lax.rsqrt(jnp.mean(xf * xf, axis=-1, keepdims=True) + EPS)
    return (y * g.astype(jnp.float32)).astype(x.dtype)


def pool_mixer(u, w_pool, scale):
    b, s, _ = u.shape
    uf = u.astype(jnp.float32).reshape(b, s, N_POOL_GROUPS, POOL_GROUP)
    t = jnp.arange(s)
    outs = []
    for gi, w in enumerate(POOL_WINDOWS):
        ug = uf[:, :, gi]
        c = jnp.cumsum(ug, axis=1)
        c_prev = jnp.pad(c, ((0, 0), (w, 0), (0, 0)))[:, :s]
        cnt = jnp.minimum(t + 1, w).astype(jnp.float32)[None, :, None]
        outs.append((c - c_prev) / cnt - ug)
    d = jnp.stack(outs, axis=2).astype(u.dtype)
    y = jnp.einsum('bsgc,gcd->bsgd', d, w_pool).reshape(b, s, POOL_WIDTH)
    return y * scale


def stick_breaking_attention(q, k, v):
    b, s_len, h, dh = q.shape
    scale = dh ** -0.5
    outs = []
    for start in range(0, s_len, Q_BLOCK):
        end = start + Q_BLOCK
        qb = q[:, start:end]
        kb = k[:, :end]
        vb = v[:, :end]
        z = jnp.einsum('bqhd,bkhd->bhqk', qb, kb,
                       preferred_element_type=jnp.float32) * scale
        t_idx = start + jnp.arange(Q_BLOCK)
        s_idx = jnp.arange(end)
        mask = s_idx[None, :] < t_idx[:, None]
        log_fail = jnp.where(mask, jax.nn.log_sigmoid(-z), 0.0)
        after = lax.cumsum(log_fail, axis=3, reverse=True) - log_fail
        log_a = jax.nn.log_sigmoid(z) + after
        a = jnp.where(mask, jnp.exp(log_a), 0.0)
        outs.append(jnp.einsum('bhqk,bkhd->bqhd', a.astype(v.dtype), vb))
    return jnp.concatenate(outs, axis=1)


def setup_inputs(seed: int = 0) -> dict:
    key = jax.random.key(seed)
    ks = jax.random.split(key, 20)
    f32 = jnp.float32

    def nrm(k, shape, fan_in):
        return jax.random.normal(k, shape, f32) * (fan_in ** -0.5)

    def gain(k, shape):
        return 1.0 + 0.05 * jax.random.normal(k, shape, f32)

    return {
        "x": jax.random.normal(ks[0], (BATCH, SEQ, D_MODEL), f32),
        "p": jax.random.normal(ks[1], (DEPTH, BATCH, SEQ, PLE_DIM), f32),
        "g_mix_pre": gain(ks[2], (DEPTH, D_MODEL)),
        "w_in": nrm(ks[3], (DEPTH, D_MODEL, IN_WIDTH), D_MODEL),
        "w_pool": nrm(ks[4], (DEPTH, N_POOL_GROUPS, POOL_GROUP, POOL_GROUP), POOL_GROUP),
        "pool_scale": gain(ks[5], (DEPTH, POOL_WIDTH)),
        "g_sb": gain(ks[6], (DEPTH, SB_WIDTH)),
        "w_out": nrm(ks[7], (DEPTH, D_MODEL, D_MODEL), D_MODEL),
        "g_mix_post": gain(ks[8], (DEPTH, D_MODEL)),
        "g_mlp_pre": gain(ks[9], (DEPTH, D_MODEL)),
        "w_up": nrm(ks[10], (DEPTH, D_MODEL, D_FF), D_MODEL),
        "w_down": nrm(ks[11], (DEPTH, D_FF, D_MODEL), D_FF),
        "g_mlp_post": gain(ks[12], (DEPTH, D_MODEL)),
        "w_ple_gate": nrm(ks[13], (DEPTH, D_MODEL, D_MODEL), D_MODEL),
        "w_ple_proj": nrm(ks[14], (DEPTH, PLE_DIM, D_MODEL), PLE_DIM),
        "g_ple": gain(ks[15], (DEPTH, D_MODEL)),
    }


def reference(x, p, g_mix_pre, w_in, w_pool, pool_scale, g_sb, w_out, g_mix_post,
              g_mlp_pre, w_up, w_down, g_mlp_post, w_ple_gate, w_ple_proj, g_ple):
    b, s, _ = x.shape
    assert s % CHUNK == 0
    h = x
    for i in range(DEPTH):
        hn = rms_norm(h, g_mix_pre[i])
        proj = hn @ w_in[i]
        u = proj[..., :POOL_WIDTH]
        q, k, v = jnp.split(proj[..., POOL_WIDTH:], 3, axis=-1)
        q = q.reshape(b, s, SB_HEADS, SB_HEAD_DIM)
        k = k.reshape(b, s, SB_HEADS, SB_HEAD_DIM)
        v = v.reshape(b, s, SB_HEADS, SB_HEAD_DIM)

        y_pool = pool_mixer(u, w_pool[i], pool_scale[i])
        o_sb = stick_breaking_attention(q, k, v)
        y_sb = rms_norm(o_sb, jnp.ones((SB_HEAD_DIM,), jnp.float32)).reshape(b, s, SB_WIDTH) * g_sb[i]

        mix = jnp.concatenate([y_pool, y_sb], axis=-1) @ w_out[i]
        h = h + rms_norm(mix, g_mix_post[i])

        m = rms_norm(h, g_mlp_pre[i]) @ w_up[i]
        m = jnp.square(jax.nn.relu(m)) @ w_down[i]
        h = h + rms_norm(m, g_mlp_post[i])

        gate = jax.nn.sigmoid(h @ w_ple_gate[i])
        e = rms_norm(p[i] @ w_ple_proj[i], g_ple[i])
        h = h + gate * e
    return h
```

```cpp
#include <hip/hip_runtime.h>
#include <hip/hip_cooperative_groups.h>
#include <cstdio>
#include <cstdint>
namespace cg = cooperative_groups;
namespace pg8 {
#define PG8_LAS __attribute__((address_space(3)))
typedef unsigned short bf16_t;
typedef short bf16x8 __attribute__((ext_vector_type(8)));
typedef float f32x4 __attribute__((ext_vector_type(4)));
typedef unsigned u32x4 __attribute__((ext_vector_type(4)));
constexpr int BM = 256, BK = 64, HALF = 128, HTB = HALF * BK * 2  , STAGE_BYTES = 8 * HTB, NXCD = 8, WGM = 8;

__host__ __device__ __forceinline__ int lds_byte(int r, int c) { const int st = (r >> 4) * 2 + (c >> 5), rr = r & 15, cc = c & 31, ob = rr * 64 + cc * 2; return st * 1024 + (ob ^ (((ob >> 9) & 1) << 5)); }
__host__ __device__ __forceinline__ void stage_rc(int b, int& R, int& C) { const int st = b / 1024, sb = b % 1024, swz = sb ^ (((sb >> 9) & 1) << 5); R = (st >> 1) * 16 + swz / 64; C = (st & 1) * 32 + (swz % 64) / 2; }
__host__ __device__ __forceinline__ int perm32(int rho) { const int n = rho >> 4, i = rho & 15; return 8 * (i >> 2) + 4 * n + (i & 3); }

struct Unit { int pm, pn; };
struct Gemm { const bf16_t* A; const bf16_t* Bt; int M, N, K; };

struct StaticOrder {
    int nM, nN, nwg, G, c;
    __host__ __device__ void init(int M, int N, int G_, int c_) { nM = M / BM; nN = N / BM; nwg = nM * nN; G = G_; c = c_; }
    __host__ __device__ bool next(int i, Unit& u) const {
        const long L = (long)i * G + c; if (L >= nwg) return false;
        int wgid = (int)L; { const int q = nwg / NXCD, r = nwg % NXCD, xcd = wgid % NXCD, off = wgid / NXCD; wgid = (xcd < r ? xcd * (q + 1) : r * (q + 1) + (xcd - r) * q) + off; }
        const int nig = WGM * nN, gid = wgid / nig, fm = gid * WGM, gsz = (nM - fm) < WGM ? (nM - fm) : WGM;
        u.pm = fm + ((wgid % nig) % gsz); u.pn = (wgid % nig) / gsz; return true;
    }
    __device__ __forceinline__ void a_ready(const Unit&) const {}
    __device__ __forceinline__ void done(const Unit&) const {}
};

__device__ __forceinline__ unsigned cvt_pk_bf16(float lo, float hi) { unsigned r; asm volatile("v_cvt_pk_bf16_f32 %0, %1, %2" : "=v"(r) : "v"(lo), "v"(hi)); return r; }
typedef float f32x2 __attribute__((ext_vector_type(2)));
typedef float f32x2_t __attribute__((ext_vector_type(2)));
typedef unsigned u32x2 __attribute__((ext_vector_type(2)));
typedef __bf16 bf16x2_t __attribute__((ext_vector_type(2)));
__device__ __forceinline__ unsigned cvtpk(float lo, float hi) { f32x2_t v = {lo, hi}; bf16x2_t b = __builtin_convertvector(v, bf16x2_t); return __builtin_bit_cast(unsigned, b); }
__device__ __forceinline__ float bflo(unsigned w) { return __builtin_bit_cast(float, w << 16); }
__device__ __forceinline__ float bfhi(unsigned w) { return __builtin_bit_cast(float, w & 0xffff0000u); }

template <int ACT, bool SS> struct EpiStore {
    static constexpr bool PERM = true, AFTER_DRAIN = false;
    bf16_t* O; int ldc; float* ss;
    __device__ __forceinline__ void operator()(const f32x4 (&acc)[2][2][4][2], const Unit& u, int wr, int wc, int fr, int fq) const {
        const int row0 = u.pm * BM + wr * 64 + fr, col0 = u.pn * BM + wc * 32 + 8 * fq;
#pragma unroll
        for (int ai = 0; ai < 2; ++ai)
#pragma unroll
            for (int m = 0; m < 4; ++m) { const int row = row0 + ai * HALF + m * 16; bf16_t* rowp = O + (size_t)row * ldc + col0; float s = 0.f;
#pragma unroll
                for (int bj = 0; bj < 2; ++bj) { f32x4 v0 = acc[ai][bj][m][0], v1 = acc[ai][bj][m][1];
                    if (ACT == 1) {
#pragma unroll
                        for (int e = 0; e < 4; ++e) { const float a = fmaxf(v0[e], 0.f), b = fmaxf(v1[e], 0.f); v0[e] = a * a; v1[e] = b * b; } }
                    if (SS) s += (v0[0] * v0[0] + v0[1] * v0[1]) + (v0[2] * v0[2] + v0[3] * v0[3]) + (v1[0] * v1[0] + v1[1] * v1[1]) + (v1[2] * v1[2] + v1[3] * v1[3]);
                    u32x4 w; w.x = cvtpk(v0[0], v0[1]); w.y = cvtpk(v0[2], v0[3]); w.z = cvtpk(v1[0], v1[1]); w.w = cvtpk(v1[2], v1[3]);
                    *(u32x4*)(rowp + bj * HALF) = w; }
                if (SS) { s += __shfl_xor(s, 16); s += __shfl_xor(s, 32); if (fq == 0) ss[(size_t)row * 16 + u.pn * 4 + wc] = s; } }
    }
};
struct EpiVT4 {
    static constexpr bool PERM = true, AFTER_DRAIN = false;
    bf16_t* O;
    __device__ __forceinline__ void operator()(const f32x4 (&acc)[2][2][4][2], const Unit& u, int wr, int wc, int fr, int fq) const {
        const int row0 = u.pm * BM + wr * 64 + fr, col0 = u.pn * BM + wc * 32 + 8 * fq;
#pragma unroll
        for (int ai = 0; ai < 2; ++ai)
#pragma unroll
            for (int m = 0; m < 4; ++m) { const int row = row0 + ai * HALF + m * 16, h = row >> 6, d = row & 63;
#pragma unroll
                for (int bj = 0; bj < 2; ++bj) { const int tok = col0 + bj * HALF, b = tok >> 13, tok4 = (tok & 8191) >> 2;
                    bf16_t* dst = O + (((size_t)(b * 8 + h) * 2048 + tok4) * 64 + d) * 4;
                    const f32x4 v0 = acc[ai][bj][m][0], v1 = acc[ai][bj][m][1];
                    u32x2 w0, w1; w0.x = cvtpk(v0[0], v0[1]); w0.y = cvtpk(v0[2], v0[3]); w1.x = cvtpk(v1[0], v1[1]); w1.y = cvtpk(v1[2], v1[3]);
                    *(u32x2*)dst = w0; *(u32x2*)(dst + 256) = w1; } }
    }
};
struct EpiFinal {
    static constexpr bool PERM = true, AFTER_DRAIN = false;
    float* out; const bf16_t* mix; const float* r2; const float* gpost; const bf16_t* eraw; const float* rstd_e; const float* g;
    __device__ __forceinline__ void operator()(const f32x4 (&acc)[2][2][4][2], const Unit& u, int wr, int wc, int fr, int fq) const {
        const int row0 = u.pm * BM + wr * 64 + fr, col0 = u.pn * BM + wc * 32 + 8 * fq;
        f32x4 gv[2][2], gp[2][2];
#pragma unroll
        for (int bj = 0; bj < 2; ++bj) { gv[bj][0] = *(const f32x4*)(g + col0 + bj * HALF); gv[bj][1] = *(const f32x4*)(g + col0 + bj * HALF + 4);
            gp[bj][0] = *(const f32x4*)(gpost + col0 + bj * HALF); gp[bj][1] = *(const f32x4*)(gpost + col0 + bj * HALF + 4); }
#pragma unroll
        for (int ai = 0; ai < 2; ++ai)
#pragma unroll
            for (int m = 0; m < 4; ++m) { const int row = row0 + ai * HALF + m * 16; const float re = rstd_e[row], rm = r2[row];
#pragma unroll
                for (int bj = 0; bj < 2; ++bj) { float* op = out + (size_t)row * 1024 + col0 + bj * HALF;
                    const f32x4 h0 = *(const f32x4*)op, h1 = *(const f32x4*)(op + 4);
                    const u32x4 ew = *(const u32x4*)(eraw + (size_t)row * 1024 + col0 + bj * HALF), mw = *(const u32x4*)(mix + (size_t)row * 1024 + col0 + bj * HALF);
                    const f32x4 e0 = {bflo(ew.x), bfhi(ew.x), bflo(ew.y), bfhi(ew.y)}, e1 = {bflo(ew.z), bfhi(ew.z), bflo(ew.w), bfhi(ew.w)};
                    const f32x4 m0 = {bflo(mw.x), bfhi(mw.x), bflo(mw.y), bfhi(mw.y)}, m1 = {bflo(mw.z), bfhi(mw.z), bflo(mw.w), bfhi(mw.w)};
                    f32x4 o0, o1;
#pragma unroll
                    for (int e = 0; e < 4; ++e) {
                        const float g0 = __builtin_amdgcn_rcpf(1.f + __builtin_amdgcn_exp2f(acc[ai][bj][m][0][e] * -1.4426950408889634f));
                        const float g1 = __builtin_amdgcn_rcpf(1.f + __builtin_amdgcn_exp2f(acc[ai][bj][m][1][e] * -1.4426950408889634f));
                        o0[e] = (h0[e] + m0[e] * rm * gp[bj][0][e]) + g0 * (e0[e] * re * gv[bj][0][e]); o1[e] = (h1[e] + m1[e] * rm * gp[bj][1][e]) + g1 * (e1[e] * re * gv[bj][1][e]); }
                    *(f32x4*)op = o0; *(f32x4*)(op + 4) = o1; }
                asm volatile("" ::: "memory"); }
    }
};
template <class Epi, class Sched, bool ALIGN_EPI = false, bool SP2 = false>
__device__ __forceinline__ void gemm_phase(PG8_LAS unsigned char* lds, const Gemm g, const Sched& S, const Epi& E) {
    const int tid = threadIdx.x, wid = __builtin_amdgcn_readfirstlane(tid >> 6), lane = tid & 63, wr = wid >> 2, wc = wid & 3, fr = lane & 15, fq = lane >> 4;
    const int K = g.K, nt = K / BK;
    unsigned voffA[2], voffB[2];
#pragma unroll
    for (int i = 0; i < 2; ++i) { int R, C; stage_rc(tid * 16 + i * 8192, R, C); const int Rb = Epi::PERM ? ((R & ~31) + perm32(R & 31)) : R;
        voffA[i] = (unsigned)(R * K + C) * 2u; voffB[i] = (unsigned)(Rb * K + C) * 2u; }
    const size_t kstep = (size_t)(BK * 2);
    const size_t hstep = (size_t)HALF * K * 2;
    const size_t tstep = 2 * hstep;
    const unsigned ldsw = (unsigned)wid * 1024u;
    const int aoff = lds_byte(wr * 64 + fr, fq * 8), boff = lds_byte(wc * 32 + fr, fq * 8);
#define PG8_SA(b, h) (((b) * 2 + (h)) * HTB)
#define PG8_SB(b, h) ((4 + (b) * 2 + (h)) * HTB)
#define PG8_STAGE(bufoff, gbase, voff) do { _Pragma("unroll") for (int _i = 0; _i < 2; ++_i) \
        __builtin_amdgcn_global_load_lds((const unsigned*)((const char*)(gbase) + (voff)[_i]), (PG8_LAS unsigned*)(lds + (bufoff) + ldsw + _i * 8192), 16, 0, 0); } while (0)
#define PG8_LDA(dst, b, h) do { _Pragma("unroll") for (int m = 0; m < 4; ++m) _Pragma("unroll") for (int k = 0; k < 2; ++k) dst[m][k] = *(const PG8_LAS bf16x8*)(lds + PG8_SA(b, h) + aoff + m * 2048 + k * 1024); } while (0)
#define PG8_LDB(dst, b, h) do { _Pragma("unroll") for (int n = 0; n < 2; ++n) _Pragma("unroll") for (int k = 0; k < 2; ++k) dst[n][k] = *(const PG8_LAS bf16x8*)(lds + PG8_SB(b, h) + boff + n * 2048 + k * 1024); } while (0)
#define PG8_MMA(ai, bj, At, Bt) do { __builtin_amdgcn_s_setprio(1); _Pragma("unroll") for (int m = 0; m < 4; ++m) _Pragma("unroll") for (int n = 0; n < 2; ++n) _Pragma("unroll") for (int k = 0; k < 2; ++k) \
        acc[ai][bj][m][n] = __builtin_amdgcn_mfma_f32_16x16x32_bf16(Bt[n][k], At[m][k], acc[ai][bj][m][n], 0, 0, 0); __builtin_amdgcn_s_setprio(0); } while (0)
#define PG8_WAIT_V(n) asm volatile("s_waitcnt vmcnt(" #n ")" ::: "memory")
#define PG8_WAIT_L(n) asm volatile("s_waitcnt lgkmcnt(" #n ")" ::: "memory")
#define PG8_BAR __builtin_amdgcn_s_barrier()
#define PG8_SCHED __builtin_amdgcn_sched_barrier(0)
    Unit cur, nxt; int ui = 0;
    if (!S.next(0, cur)) return;
    f32x4 acc[2][2][4][2];
#pragma unroll
    for (int a = 0; a < 2; ++a)
#pragma unroll
        for (int b = 0; b < 2; ++b)
#pragma unroll
            for (int m = 0; m < 4; ++m)
#pragma unroll
                for (int n = 0; n < 2; ++n) acc[a][b][m][n] = (f32x4){0.f, 0.f, 0.f, 0.f};
    bf16x8 At[4][2], B0[2][2], B1[2][2];
    const char* cA = (const char*)g.A + (size_t)cur.pm * tstep; const char* cB = (const char*)g.Bt + (size_t)cur.pn * tstep;
    S.a_ready(cur);
    if constexpr (SP2) {
        PG8_STAGE(PG8_SB(0, 0), cB, voffB); PG8_STAGE(PG8_SB(0, 1), cB + hstep, voffB); PG8_STAGE(PG8_SA(0, 0), cA, voffA); PG8_STAGE(PG8_SA(0, 1), cA + hstep, voffA);
        if (wr == 1) PG8_BAR;
        PG8_WAIT_V(2); PG8_BAR;
        PG8_STAGE(PG8_SB(1, 0), cB + kstep, voffB); PG8_STAGE(PG8_SA(1, 0), cA + kstep, voffA); PG8_STAGE(PG8_SB(1, 1), cB + hstep + kstep, voffB);
        PG8_WAIT_V(6); PG8_BAR;
    } else {
        PG8_STAGE(PG8_SB(0, 0), cB, voffB); PG8_STAGE(PG8_SA(0, 0), cA, voffA); PG8_STAGE(PG8_SB(0, 1), cB + hstep, voffB); PG8_STAGE(PG8_SA(0, 1), cA + hstep, voffA);
        if (wr == 1) PG8_BAR;
        PG8_WAIT_V(4); PG8_BAR;
        PG8_STAGE(PG8_SB(1, 0), cB + kstep, voffB); PG8_STAGE(PG8_SA(1, 0), cA + kstep, voffA); PG8_STAGE(PG8_SB(1, 1), cB + hstep + kstep, voffB);
        PG8_WAIT_V(6); PG8_BAR;
    }
    for (;;) {
        const bool has_next = S.next(ui + 1, nxt);
        const char* nA = has_next ? (const char*)g.A + (size_t)nxt.pm * tstep : cA; const char* nB = has_next ? (const char*)g.Bt + (size_t)nxt.pn * tstep : cB;
        for (int t = 0; t < nt; t += 2) {
            const bool last = (t == nt - 2);
            const char* a1 = cA + (size_t)(t + 1) * kstep;
            const char* a2 = last ? nA : cA + (size_t)(t + 2) * kstep; const char* b2 = last ? nB : cB + (size_t)(t + 2) * kstep;
            const char* a3 = a2 + kstep; const char* b3 = b2 + kstep;
            if (last && has_next) S.a_ready(nxt);
            if constexpr (SP2) {
            PG8_LDB(B0, 0, 0); PG8_LDB(B1, 0, 1); PG8_SCHED; PG8_LDA(At, 0, 0); PG8_STAGE(PG8_SA(1, 1), a1 + hstep, voffA);
            PG8_WAIT_V(8); PG8_WAIT_L(0); PG8_BAR; PG8_MMA(0, 0, At, B0); PG8_MMA(0, 1, At, B1); PG8_BAR; PG8_SCHED;
            PG8_LDA(At, 0, 1); PG8_STAGE(PG8_SB(0, 0), b2, voffB); PG8_STAGE(PG8_SB(0, 1), b2 + hstep, voffB); PG8_STAGE(PG8_SA(0, 0), a2, voffA);
            PG8_WAIT_V(8); PG8_WAIT_L(0); PG8_BAR; PG8_MMA(1, 0, At, B0); PG8_MMA(1, 1, At, B1); PG8_BAR; PG8_SCHED;
            PG8_LDB(B0, 1, 0); PG8_LDB(B1, 1, 1); PG8_SCHED; PG8_LDA(At, 1, 0); PG8_STAGE(PG8_SA(0, 1), a2 + hstep, voffA);
            PG8_WAIT_V(8); PG8_WAIT_L(0); PG8_BAR; PG8_MMA(0, 0, At, B0); PG8_MMA(0, 1, At, B1); PG8_BAR; PG8_SCHED;
            PG8_LDA(At, 1, 1); PG8_STAGE(PG8_SB(1, 0), b3, voffB); PG8_STAGE(PG8_SB(1, 1), b3 + hstep, voffB); PG8_STAGE(PG8_SA(1, 0), a3, voffA);
            PG8_WAIT_V(8); PG8_WAIT_L(0); PG8_BAR; PG8_MMA(1, 0, At, B0); PG8_MMA(1, 1, At, B1); PG8_BAR; PG8_SCHED;
            } else {
            PG8_LDB(B0, 0, 0); PG8_SCHED; PG8_LDA(At, 0, 0); PG8_STAGE(PG8_SA(1, 1), a1 + hstep, voffA);
            PG8_WAIT_L(8); PG8_BAR; PG8_WAIT_L(0); PG8_MMA(0, 0, At, B0); PG8_BAR; PG8_SCHED;
            PG8_LDB(B1, 0, 1); PG8_STAGE(PG8_SB(0, 0), b2, voffB);
            PG8_BAR; PG8_WAIT_L(0); PG8_MMA(0, 1, At, B1); PG8_BAR;
            PG8_LDA(At, 0, 1); PG8_STAGE(PG8_SA(0, 0), a2, voffA);
            PG8_BAR; PG8_WAIT_L(0); PG8_MMA(1, 0, At, B0); PG8_BAR; PG8_SCHED;
            PG8_STAGE(PG8_SB(0, 1), b2 + hstep, voffB);
            PG8_WAIT_V(6); PG8_BAR; PG8_MMA(1, 1, At, B1); PG8_BAR;
            PG8_LDB(B0, 1, 0); PG8_SCHED; PG8_LDA(At, 1, 0); PG8_STAGE(PG8_SA(0, 1), a2 + hstep, voffA);
            PG8_WAIT_L(8); PG8_BAR; PG8_WAIT_L(0); PG8_MMA(0, 0, At, B0); PG8_BAR; PG8_SCHED;
            PG8_LDB(B1, 1, 1); PG8_STAGE(PG8_SB(1, 0), b3, voffB);
            PG8_BAR; PG8_WAIT_L(0); PG8_MMA(0, 1, At, B1); PG8_BAR;
            PG8_LDA(At, 1, 1); PG8_STAGE(PG8_SA(1, 0), a3, voffA);
            PG8_BAR; PG8_WAIT_L(0); PG8_MMA(1, 0, At, B0); PG8_BAR; PG8_SCHED;
            PG8_STAGE(PG8_SB(1, 1), b3 + hstep, voffB);
            PG8_WAIT_V(6); PG8_BAR; PG8_MMA(1, 1, At, B1); PG8_BAR;
            }
        }
        if constexpr (ALIGN_EPI) { if (wr == 0) PG8_BAR; }
        if constexpr (!Epi::AFTER_DRAIN) { E(acc, cur, wr, wc, fr, fq); S.done(cur); }
        if (!has_next) break;
#pragma unroll
        for (int a = 0; a < 2; ++a)
#pragma unroll
            for (int b = 0; b < 2; ++b)
#pragma unroll
                for (int m = 0; m < 4; ++m)
#pragma unroll
                    for (int n = 0; n < 2; ++n) acc[a][b][m][n] = (f32x4){0.f, 0.f, 0.f, 0.f};
        cur = nxt; cA = nA; cB = nB; ++ui;
        if constexpr (ALIGN_EPI) { if (wr == 1) PG8_BAR; }
    }
    PG8_WAIT_V(0);
    if constexpr (!ALIGN_EPI) { if (wr == 0) PG8_BAR; }
    PG8_BAR;
    if constexpr (Epi::AFTER_DRAIN) { E.fused(acc, cur, wr, wc, fr, fq, lds, wid, lane); S.done(cur); }
#undef PG8_SA
#undef PG8_SB
#undef PG8_STAGE
#undef PG8_LDA
#undef PG8_LDB
#undef PG8_MMA
#undef PG8_WAIT_V
#undef PG8_WAIT_L
#undef PG8_BAR
#undef PG8_SCHED
}
}
#ifndef PG8_SP2
#define PG8_SP2 true
#endif
#ifndef PG8_ALIGN
#define PG8_ALIGN true
#endif
#ifndef REPV
#define REPV {1,1,1,1,1,1,1,1,1}
#endif
constexpr int REP[9] = REPV;
#ifndef REP1V
#define REP1V {1,1,1}
#endif
constexpr int REP1[3] = REP1V;
#ifndef MK_MULTI
#define MK_MULTI 0
#endif
constexpr int NWAVES = 8;
constexpr int BATCH = 2, SEQ = 8192, D = 1024, FF = 4096, PLE = 256, NH = 8, HD = 64;
constexpr int M = BATCH * SEQ;
constexpr int LDP = 1536;
constexpr float EPS = 1e-6f;
constexpr int N_PHASES = 9;
constexpr size_t MiB = 1u << 20;
constexpr size_t WS_CTL = 0, CTL_ZERO_BYTES = 65536;
constexpr size_t WS_WIN = 1 * MiB, WS_WPLE = 5 * MiB, WS_WOUT = 6 * MiB, WS_WUP = 8 * MiB, WS_WDOWN = 16 * MiB, WS_WGATE = 24 * MiB;
constexpr size_t WS_SS1 = 26 * MiB, WS_SS2 = 27 * MiB, WS_SSE = 28 * MiB, WS_RSTDE = 29 * MiB;
constexpr size_t WS_A = 32 * MiB;
constexpr size_t WS_PROJ = 32 * MiB, WS_VT = 80 * MiB, WS_PB = 128 * MiB;
constexpr size_t WS_XN = 160 * MiB, WS_ERAW = 192 * MiB, WS_MIX = 224 * MiB, WS_END = 256 * MiB;
constexpr size_t WS_MIXIN = WS_XN;
constexpr int RING_BYTES = 131072, MISC_OFF = RING_BYTES + 320, LDS_BYTES = 147456;

#define GAS __attribute__((address_space(1)))
#define LAS __attribute__((address_space(3)))
typedef unsigned short bf16;
typedef unsigned v4u __attribute__((ext_vector_type(4)));
typedef unsigned v2u __attribute__((ext_vector_type(2)));
typedef float f32x4 __attribute__((ext_vector_type(4)));
typedef float f32x16 __attribute__((ext_vector_type(16)));
typedef short bf16x8 __attribute__((ext_vector_type(8)));
typedef short s16x4 __attribute__((ext_vector_type(4)));
using pg8::cvtpk; using pg8::bflo; using pg8::bfhi;
#define LDS_WAIT() asm volatile("s_waitcnt lgkmcnt(0)" ::: "memory")
#define XB_TMO      128
#define XB_XCNT(j)  (256  + 64 * (j))
#define XB_XSUB(j)  (1280 + 64 * (j))
#define XB_XGEN(j)  (2304 + 64 * (j))
#define XB_TOP      3328
#define XB_TOPGEN   3392
#define XCD_BAR_WORDS 3456
#define XB_SPIN_CAP (1u << 18)

__device__ __forceinline__ unsigned xb_ld(unsigned* p)              { return __hip_atomic_load(p, __ATOMIC_RELAXED, __HIP_MEMORY_SCOPE_AGENT); }
__device__ __forceinline__ unsigned xb_add(unsigned* p, unsigned v) { return __hip_atomic_fetch_add(p, v, __ATOMIC_RELAXED, __HIP_MEMORY_SCOPE_AGENT); }
__device__ __forceinline__ unsigned xb_xcc_id() { return (unsigned)__builtin_amdgcn_s_getreg((3 << 11) | 20) & 0xFu; }
#define XB_SPIN(cond, bar) do { unsigned _sp = 0; while (cond) { __builtin_amdgcn_s_sleep(1); \
    if ((++_sp & 255u) == 0u) { if (xb_ld(&(bar)[XB_TMO])) break; if (_sp > XB_SPIN_CAP) { atomicAdd(&(bar)[XB_TMO], 1u); break; } } } } while (0)

struct XcdBarrier {
    unsigned* bar; unsigned x;
    volatile LAS unsigned* st;
};

__device__ __forceinline__ XcdBarrier xcd_barrier_post(unsigned* bar, volatile LAS unsigned* st) {
    XcdBarrier b; b.bar = bar; b.x = xb_xcc_id(); b.st = st;
    if (threadIdx.x == 0) st[2] = xb_add(&bar[XB_XCNT(b.x)], 1u);
    return b;
}
__device__ __forceinline__ void xcd_barrier_complete(unsigned* bar, unsigned x, unsigned& nloc, unsigned& nx) {
    const unsigned G = gridDim.x * gridDim.y * gridDim.z;
    unsigned sum, cnt, mine, sp = 0u;
    for (;;) {
        sum = 0u; cnt = 0u; mine = 0u;
#pragma unroll
        for (unsigned j = 0; j < 16; ++j) { const unsigned c = xb_ld(&bar[XB_XCNT(j)]); sum += c; cnt += (c > 0u) ? 1u : 0u; mine = (j == x) ? c : mine; }
        if (sum == G) break;
        __builtin_amdgcn_s_sleep(1);
        if ((++sp & 255u) == 0u) { if (xb_ld(&bar[XB_TMO])) break; if (sp > XB_SPIN_CAP) { atomicAdd(&bar[XB_TMO], 1u); break; } }
    }
    nloc = mine > 0u ? mine : 1u; nx = cnt > 0u ? cnt : 1u;
}

__device__ __forceinline__ void xcd_barrier(const XcdBarrier& b) {
    asm volatile("s_waitcnt vmcnt(0)" ::: "memory");
    __syncthreads();
    if (threadIdx.x == 0) {
        unsigned* bar = b.bar;
        __builtin_amdgcn_s_waitcnt(0);
        unsigned nloc = b.st[0], nx = b.st[1];
        if (nloc == 0u) { xcd_barrier_complete(bar, b.x, nloc, nx); b.st[0] = nloc; b.st[1] = nx; }
        const unsigned old = xb_add(&bar[XB_XSUB(b.x)], 1u);
        const unsigned gen = old / nloc;
        if (old + 1u == (gen + 1u) * nloc) {
            __builtin_amdgcn_fence(__ATOMIC_RELEASE, "agent");
            asm volatile("s_waitcnt vmcnt(0)" ::: "memory");
            const unsigned og = xb_add(&bar[XB_TOP], 1u);
            const unsigned tg = og / nx;
            if (og + 1u == (tg + 1u) * nx) xb_add(&bar[XB_TOPGEN], 1u);
            else XB_SPIN(xb_ld(&bar[XB_TOPGEN]) == tg, bar);
            __builtin_amdgcn_fence(__ATOMIC_ACQUIRE, "agent");
            xb_add(&bar[XB_XGEN(b.x)], 1u);
            asm volatile("s_waitcnt vmcnt(0)" ::: "memory");
        } else {
            XB_SPIN(xb_ld(&bar[XB_XGEN(b.x)]) == gen, bar);
            __builtin_amdgcn_fence(__ATOMIC_ACQUIRE, "agent");
            asm volatile("s_waitcnt vmcnt(0)" ::: "memory");
        }
    }
    __syncthreads();
}

__device__ __forceinline__ void xcd_barrier_local(const XcdBarrier& b) {
    asm volatile("s_waitcnt vmcnt(0)" ::: "memory");
    __syncthreads();
    if (threadIdx.x == 0) {
        unsigned* bar = b.bar;
        __builtin_amdgcn_s_waitcnt(0);
        const unsigned nloc = b.st[0];
        const unsigned old = xb_add(&bar[XB_XSUB(b.x)], 1u);
        const unsigned gen = old / nloc;
        if (old + 1u == (gen + 1u) * nloc) xb_add(&bar[XB_XGEN(b.x)], 1u);
        else XB_SPIN(xb_ld(&bar[XB_XGEN(b.x)]) == gen, bar);
        __builtin_amdgcn_fence(__ATOMIC_ACQUIRE, "agent");
        asm volatile("s_waitcnt vmcnt(0)" ::: "memory");
    }
    __syncthreads();
}


struct Args { const float* in[16]; float* out; unsigned char* ws; int ph_lo, ph_hi; };

__device__ __forceinline__ float wave_sum(float v) {
#pragma unroll
    for (int o = 1; o < 64; o <<= 1) v += __shfl_xor(v, o);
    return v;
}
__device__ __forceinline__ void p0_transpose_item(const float* W, int N, bf16* WT, int ldwt, int coff, LAS float* scr, int kb, int nb, int lane) {
    const int k0 = 64 * kb, n0 = 32 * nb;
#pragma unroll 8
    for (int i = 0; i < 32; ++i) { const int kk = 2 * i + (lane >> 5); scr[kk * 33 + (lane & 31)] = W[(size_t)(k0 + kk) * N + n0 + (lane & 31)]; }
    LDS_WAIT(); asm volatile("" ::: "memory");
    const int c = lane & 7;
#pragma unroll
    for (int j = 0; j < 4; ++j) { const int n = (lane >> 3) + 8 * j; const LAS float* s = scr + (8 * c) * 33 + n;
        v4u o; o.x = cvtpk(s[0 * 33], s[1 * 33]); o.y = cvtpk(s[2 * 33], s[3 * 33]); o.z = cvtpk(s[4 * 33], s[5 * 33]); o.w = cvtpk(s[6 * 33], s[7 * 33]);
        *(v4u*)(WT + (size_t)(n0 + n) * ldwt + coff + k0 + 8 * c) = o; }
    LDS_WAIT(); asm volatile("" ::: "memory");
}

__device__ __forceinline__ void p0_prologue(const Args& a, LAS unsigned char* lds, int tid, int lane, int wave, int G) {
    unsigned char* ws = a.ws;
    const float *x = a.in[0], *p = a.in[1], *g_pre = a.in[2], *w_in = a.in[3], *w_pool = a.in[4], *pool_scale = a.in[5], *w_out = a.in[7],
                *w_up = a.in[10], *w_down = a.in[11], *w_gate = a.in[13], *w_ple = a.in[14];
    bf16 *WinT = (bf16*)(ws + WS_WIN), *WpleT = (bf16*)(ws + WS_WPLE), *WoutT = (bf16*)(ws + WS_WOUT), *WupT = (bf16*)(ws + WS_WUP), *WdownT = (bf16*)(ws + WS_WDOWN), *WgateT = (bf16*)(ws + WS_WGATE);
    bf16 *XN = (bf16*)(ws + WS_XN), *PB = (bf16*)(ws + WS_PB);
    for (int item = blockIdx.x; item < 128; item += G) {
        const int g = item >> 5, n0 = (item & 31) * 32;
        LAS float* wps = (LAS float*)lds;
        LAS float* wo = (LAS float*)(lds + 128 * 129 * 4);
        for (int i = 0; i < 32; ++i) { const int idx = i * 512 + tid, c = idx >> 7, d = idx & 127; wps[c * 129 + d] = w_pool[(size_t)g * 16384 + idx] * pool_scale[g * 128 + d]; }
        for (int i = 0; i < 8; ++i) { const int idx = i * 512 + tid, d = idx >> 5, nn = idx & 31; wo[idx] = w_out[(size_t)(g * 128 + d) * 1024 + n0 + nn]; }
        __syncthreads();
        const int c = tid & 127, nq = tid >> 7;
        float acc[8];
#pragma unroll
        for (int j = 0; j < 8; ++j) acc[j] = 0.f;
#pragma unroll 4
        for (int d = 0; d < 128; ++d) { const float av = wps[c * 129 + d]; const f32x4 b0 = *(const LAS f32x4*)(wo + d * 32 + nq * 8), b1 = *(const LAS f32x4*)(wo + d * 32 + nq * 8 + 4);
#pragma unroll
            for (int j = 0; j < 4; ++j) { acc[j] += av * b0[j]; acc[4 + j] += av * b1[j]; } }
#pragma unroll
        for (int j = 0; j < 8; ++j) WoutT[(size_t)(n0 + nq * 8 + j) * 1024 + g * 128 + c] = (bf16)(cvtpk(acc[j], 0.f) & 0xffffu);
        __syncthreads();
    }
    LAS float* scr = (LAS float*)(lds + wave * 16384);
    const int gw = blockIdx.x * NWAVES + wave, NGW = G * NWAVES;
    {
        constexpr int I_IN = 16 * 64, I_PLE = 4 * 32, NITEMS = I_IN + I_PLE;
        for (int it = gw; it < NITEMS; it += NGW) {
            int r = it;
            if (r < I_IN) { p0_transpose_item(w_in, 2048, WinT, 1024, 0, scr, r / 64, r % 64, lane); continue; } r -= I_IN;
            p0_transpose_item(w_ple, 1024, WpleT, 256, 0, scr, r / 32, r % 32, lane);
        }
    }
    {
        f32x4 gv[4];
#pragma unroll
        for (int j = 0; j < 4; ++j) gv[j] = *(const f32x4*)(g_pre + 4 * lane + 256 * j);
        for (int m = gw; m < M; m += NGW) {
            const f32x4* xr = (const f32x4*)(x + (size_t)m * D) + lane; f32x4 v[4]; float s = 0.f;
#pragma unroll
            for (int j = 0; j < 4; ++j) { v[j] = xr[64 * j]; s += (v[j].x * v[j].x + v[j].y * v[j].y) + (v[j].z * v[j].z + v[j].w * v[j].w); }
            const float rstd = 1.f / sqrtf(wave_sum(s) * (1.f / D) + EPS);
            v2u* o8 = (v2u*)(XN + (size_t)m * D) + lane;
#pragma unroll
            for (int j = 0; j < 4; ++j) { const f32x4 y = v[j] * rstd * gv[j]; v2u w; w.x = cvtpk(y.x, y.y); w.y = cvtpk(y.z, y.w); o8[64 * j] = w; }
        }
    }
    for (size_t i = (size_t)gw * 64 + lane; i < (size_t)M * PLE / 8; i += (size_t)NGW * 64) {
        const f32x4 a0 = *(const f32x4*)(p + i * 8), a1 = *(const f32x4*)(p + i * 8 + 4);
        v4u w; w.x = cvtpk(a0.x, a0.y); w.y = cvtpk(a0.z, a0.w); w.z = cvtpk(a1.x, a1.y); w.w = cvtpk(a1.z, a1.w);
        *(v4u*)(PB + i * 8) = w;
    }
}

__device__ __forceinline__ void late_weights(const Args& a, LAS unsigned char* lds, int lane, int wave, int G) {
    unsigned char* ws = a.ws;
    const float *w_out = a.in[7], *w_up = a.in[10], *w_down = a.in[11], *w_gate = a.in[13];
    bf16 *WoutT = (bf16*)(ws + WS_WOUT), *WupT = (bf16*)(ws + WS_WUP), *WdownT = (bf16*)(ws + WS_WDOWN), *WgateT = (bf16*)(ws + WS_WGATE);
    LAS float* scr = (LAS float*)(lds + wave * 16384);
    const int gw = blockIdx.x * NWAVES + wave, NGW = G * NWAVES;
    constexpr int I_OUT = 8 * 32, I_UP = 16 * 128, I_DOWN = 64 * 32, I_GATE = 16 * 32, NITEMS = I_OUT + I_UP + I_DOWN + I_GATE;
    for (int it = gw; it < NITEMS; it += NGW) {
        int r = it;
        if (r < I_OUT) { p0_transpose_item(w_out + (size_t)512 * 1024, 1024, WoutT, 1024, 512, scr, r / 32, r % 32, lane); continue; } r -= I_OUT;
        if (r < I_UP) { p0_transpose_item(w_up, 4096, WupT, 1024, 0, scr, r / 128, r % 128, lane); continue; } r -= I_UP;
        if (r < I_DOWN) { p0_transpose_item(w_down, 1024, WdownT, 4096, 0, scr, r / 32, r % 32, lane); continue; } r -= I_DOWN;
        p0_transpose_item(w_gate, 1024, WgateT, 1024, 0, scr, r / 32, r % 32, lane);
    }
}

__device__ __forceinline__ void pool_acc(float (&s)[8], const v4u v, const float m) {
    s[0] += m * bflo(v.x); s[1] += m * bfhi(v.x); s[2] += m * bflo(v.y); s[3] += m * bfhi(v.y); s[4] += m * bflo(v.z); s[5] += m * bfhi(v.z); s[6] += m * bflo(v.w); s[7] += m * bfhi(v.w);
}
template <int W> __device__ __forceinline__ void pool_item(const bf16* PROJ, bf16* MIXIN, int m0, int col) {
    const int t0 = m0 & (SEQ - 1);
    const bf16* up = PROJ + (size_t)m0 * LDP + col;
    v4u v[W + 7];
#pragma unroll
    for (int j = 0; j < W + 7; ++j) { const int dr = j - (W - 1); const int drc = (t0 + dr < 0) ? -t0 : dr; v[j] = *(const v4u*)(up + (ptrdiff_t)drc * LDP); }
    float s[8];
#pragma unroll
    for (int e = 0; e < 8; ++e) s[e] = 0.f;
#pragma unroll
    for (int j = 0; j < W - 1; ++j) pool_acc(s, v[j], (t0 + j - (W - 1) >= 0) ? 1.f : 0.f);
#pragma unroll
    for (int i = 0; i < 8; ++i) {
        const v4u c = v[W - 1 + i];
        pool_acc(s, c, 1.f);
        const int n = (t0 + i + 1 < W) ? (t0 + i + 1) : W;
        const float inv = __builtin_amdgcn_rcpf((float)n);
        v4u o; o.x = cvtpk(s[0] * inv - bflo(c.x), s[1] * inv - bfhi(c.x)); o.y = cvtpk(s[2] * inv - bflo(c.y), s[3] * inv - bfhi(c.y));
        o.z = cvtpk(s[4] * inv - bflo(c.z), s[5] * inv - bfhi(c.z)); o.w = cvtpk(s[6] * inv - bflo(c.w), s[7] * inv - bfhi(c.w));
        *(v4u*)(MIXIN + (size_t)(m0 + i) * D + col) = o;
        pool_acc(s, v[i], (t0 + i - (W - 1) >= 0) ? -1.f : 0.f);
    }
}
__device__ __forceinline__ void p2_pool(const bf16* PROJ, bf16* MIXIN, int gtid, int nthreads) {
    for (int item = gtid; item < (M / 8) * 64; item += nthreads) {
        const int cgl = item & 15, rsub = (item >> 4) & 3, g = (item >> 6) & 3, rb = (item >> 8) * 4 + rsub;
        const int col = g * 128 + cgl * 8, m0 = rb * 8;
        if (g == 0) pool_item<2>(PROJ, MIXIN, m0, col); else if (g == 1) pool_item<4>(PROJ, MIXIN, m0, col); else if (g == 2) pool_item<8>(PROJ, MIXIN, m0, col); else pool_item<16>(PROJ, MIXIN, m0, col);
    }
}

#define MFMA32(a, b, c) __builtin_amdgcn_mfma_f32_32x32x16_bf16((a), (b), (c), 0, 0, 0)
__device__ __forceinline__ void sb_load_tile(bf16x8 (&kf)[4], s16x4 (&vf)[2][2][2], const bf16* kp, const bf16* vp) {
#pragma unroll
    for (int ks = 0; ks < 4; ++ks) kf[ks] = *(const bf16x8*)(kp + 16 * ks);
#pragma unroll
    for (int db = 0; db < 2; ++db)
#pragma unroll
        for (int s = 0; s < 2; ++s)
#pragma unroll
            for (int hf = 0; hf < 2; ++hf) vf[db][s][hf] = *(const s16x4*)(vp + ((4 * s + 2 * hf) * 64 + 32 * db) * 4);
}
__device__ __forceinline__ void sb_unit(const bf16* PROJ, const bf16* VT, const float* g_sb, bf16* MIXIN, int b, int h, int qb, int lane) {
    const int r = lane & 31, hi = lane >> 5, t0 = qb * 32;
    const size_t mrow0 = (size_t)b * SEQ + t0;
    bf16x8 qf[4];
    { const bf16* qp = PROJ + (mrow0 + r) * LDP + 512 + h * HD + 8 * hi;
#pragma unroll
      for (int ks = 0; ks < 4; ++ks) qf[ks] = *(const bf16x8*)(qp + 16 * ks); }
    f32x16 o0, o1;
#pragma unroll
    for (int i = 0; i < 16; ++i) { o0[i] = 0.f; o1[i] = 0.f; }
    float carry = 1.f;
    const bf16* kbase = PROJ + ((size_t)b * SEQ + r) * LDP + 1024 + h * HD + 8 * hi;
    const bf16* vbase = VT + ((size_t)(b * NH + h) * (SEQ / 4) + hi) * 256 + r * 4;
    bf16x8 kf[4], kn[4]; s16x4 vf[2][2][2], vn[2][2][2];
    sb_load_tile(kf, vf, kbase + (size_t)t0 * LDP, vbase + (size_t)t0 * 64);
    for (int kt = t0; kt >= 0; kt -= 32) {
        const bool more = kt >= 32;
        if (more) sb_load_tile(kn, vn, kbase + (size_t)(kt - 32) * LDP, vbase + (size_t)(kt - 32) * 64);
        f32x16 s;
#pragma unroll
        for (int i = 0; i < 16; ++i) s[i] = 0.f;
#pragma unroll
        for (int ks = 0; ks < 4; ++ks) s = MFMA32(kf[ks], qf[ks], s);
        const bool diag = (kt == t0);
        float f[16], gp[4], pp[4], a[16];
#pragma unroll
        for (int i = 0; i < 16; ++i) {
            const int kr = (i & 3) + 8 * (i >> 2) + 4 * hi;
            const float e = __builtin_amdgcn_exp2f(s[i] * (0.125f * 1.4426950408889634f));
            const float fi = __builtin_amdgcn_rcpf(1.f + e);
            f[i] = (!diag || (kr < r)) ? fi : 1.f;
        }
#pragma unroll
        for (int g4 = 0; g4 < 4; ++g4) gp[g4] = (f[4 * g4] * f[4 * g4 + 1]) * (f[4 * g4 + 2] * f[4 * g4 + 3]);
#pragma unroll
        for (int g4 = 0; g4 < 4; ++g4) pp[g4] = __shfl_xor(gp[g4], 32);
        float base = carry;
#pragma unroll
        for (int g4 = 3; g4 >= 0; --g4) {
            float run = (hi == 0) ? base * pp[g4] : base;
#pragma unroll
            for (int e = 3; e >= 0; --e) { const int i = 4 * g4 + e; const float nxt = run * f[i]; a[i] = run - nxt; run = nxt; }
            base *= gp[g4] * pp[g4];
        }
        carry = base;
        bf16x8 a0, a1;
        { v4u w0, w1; w0.x = cvtpk(a[0], a[1]); w0.y = cvtpk(a[2], a[3]); w0.z = cvtpk(a[4], a[5]); w0.w = cvtpk(a[6], a[7]);
          w1.x = cvtpk(a[8], a[9]); w1.y = cvtpk(a[10], a[11]); w1.z = cvtpk(a[12], a[13]); w1.w = cvtpk(a[14], a[15]);
          a0 = __builtin_bit_cast(bf16x8, w0); a1 = __builtin_bit_cast(bf16x8, w1); }
        {
            const bf16x8 v00 = __builtin_shufflevector(vf[0][0][0], vf[0][0][1], 0, 1, 2, 3, 4, 5, 6, 7), v01 = __builtin_shufflevector(vf[0][1][0], vf[0][1][1], 0, 1, 2, 3, 4, 5, 6, 7);
            const bf16x8 v10 = __builtin_shufflevector(vf[1][0][0], vf[1][0][1], 0, 1, 2, 3, 4, 5, 6, 7), v11 = __builtin_shufflevector(vf[1][1][0], vf[1][1][1], 0, 1, 2, 3, 4, 5, 6, 7);
            o0 = MFMA32(v00, a0, o0); o0 = MFMA32(v01, a1, o0);
            o1 = MFMA32(v10, a0, o1); o1 = MFMA32(v11, a1, o1);
        }
        if (__all(carry < 1e-37f)) break;
        if (more) {
#pragma unroll
            for (int ks = 0; ks < 4; ++ks) kf[ks] = kn[ks];
#pragma unroll
            for (int db = 0; db < 2; ++db)
#pragma unroll
                for (int s2 = 0; s2 < 2; ++s2)
#pragma unroll
                    for (int hf = 0; hf < 2; ++hf) vf[db][s2][hf] = vn[db][s2][hf];
        }
    }
    float ss = 0.f;
#pragma unroll
    for (int i = 0; i < 16; ++i) ss += o0[i] * o0[i] + o1[i] * o1[i];
    ss += __shfl_xor(ss, 32);
    const float rstd = 1.f / sqrtf(ss * (1.f / HD) + EPS);
    bf16* op = MIXIN + (mrow0 + r) * D + 512 + h * HD + 4 * hi;
    const float* gp = g_sb + h * HD + 4 * hi;
#pragma unroll
    for (int g4 = 0; g4 < 4; ++g4) {
        const f32x4 ga = *(const f32x4*)(gp + 8 * g4), gb = *(const f32x4*)(gp + 32 + 8 * g4);
        v2u wa, wb;
        wa.x = cvtpk(o0[4 * g4] * rstd * ga.x, o0[4 * g4 + 1] * rstd * ga.y); wa.y = cvtpk(o0[4 * g4 + 2] * rstd * ga.z, o0[4 * g4 + 3] * rstd * ga.w);
        wb.x = cvtpk(o1[4 * g4] * rstd * gb.x, o1[4 * g4 + 1] * rstd * gb.y); wb.y = cvtpk(o1[4 * g4 + 2] * rstd * gb.z, o1[4 * g4 + 3] * rstd * gb.w);
        *(v2u*)(op + 8 * g4) = wa; *(v2u*)(op + 32 + 8 * g4) = wb;
    }
}

__device__ __forceinline__ void p4_rows(const float* x, const bf16* MIX, const float* SS, const float* g_post, const float* g_pre2, float* out, bf16* XN, int mfirst, int mend, int mstep, int lane) {
    f32x4 gp[4], gq[4];
#pragma unroll
    for (int j = 0; j < 4; ++j) { gp[j] = *(const f32x4*)(g_post + 4 * lane + 256 * j); gq[j] = *(const f32x4*)(g_pre2 + 4 * lane + 256 * j); }
    for (int m = mfirst; m < mend; m += mstep) {
        const f32x4* sp = (const f32x4*)(SS + (size_t)m * 16); const f32x4 s0 = sp[0], s1 = sp[1], s2 = sp[2], s3 = sp[3];
        const float tot = ((s0.x + s0.y) + (s0.z + s0.w)) + ((s1.x + s1.y) + (s1.z + s1.w)) + ((s2.x + s2.y) + (s2.z + s2.w)) + ((s3.x + s3.y) + (s3.z + s3.w));
        const float r1 = 1.f / sqrtf(tot * (1.f / D) + EPS);
        const f32x4* xr = (const f32x4*)(x + (size_t)m * D) + lane; const v2u* mr = (const v2u*)(MIX + (size_t)m * D) + lane;
        f32x4 hv[4]; float q = 0.f;
#pragma unroll
        for (int j = 0; j < 4; ++j) { const f32x4 xv = xr[64 * j]; const v2u mw = mr[64 * j]; const f32x4 mv = {bflo(mw.x), bfhi(mw.x), bflo(mw.y), bfhi(mw.y)};
            hv[j] = xv + mv * r1 * gp[j]; q += (hv[j].x * hv[j].x + hv[j].y * hv[j].y) + (hv[j].z * hv[j].z + hv[j].w * hv[j].w); }
        const float r2 = 1.f / sqrtf(wave_sum(q) * (1.f / D) + EPS);
        f32x4* orow = (f32x4*)(out + (size_t)m * D) + lane; v2u* nrow = (v2u*)(XN + (size_t)m * D) + lane;
#pragma unroll
        for (int j = 0; j < 4; ++j) { orow[64 * j] = hv[j]; const f32x4 y = hv[j] * r2 * gq[j]; v2u w; w.x = cvtpk(y.x, y.y); w.y = cvtpk(y.z, y.w); nrow[64 * j] = w; }
    }
}
__device__ __forceinline__ void p7_rows(const bf16* MIX, const float* SS, const float* SSE, const float* g_post, const float* h1, bf16* XN, float* RSTDE, float* RSTD2, int mfirst, int mend, int mstep, int lane) {
    f32x4 gp[4];
#pragma unroll
    for (int j = 0; j < 4; ++j) gp[j] = *(const f32x4*)(g_post + 4 * lane + 256 * j);
    for (int m = mfirst; m < mend; m += mstep) {
        const f32x4* sp = (const f32x4*)(SS + (size_t)m * 16); const f32x4 s0 = sp[0], s1 = sp[1], s2 = sp[2], s3 = sp[3];
        const float tot = ((s0.x + s0.y) + (s0.z + s0.w)) + ((s1.x + s1.y) + (s1.z + s1.w)) + ((s2.x + s2.y) + (s2.z + s2.w)) + ((s3.x + s3.y) + (s3.z + s3.w));
        const float r1 = 1.f / sqrtf(tot * (1.f / D) + EPS);
        const f32x4* ep = (const f32x4*)(SSE + (size_t)m * 16); const f32x4 e0 = ep[0], e1 = ep[1], e2 = ep[2], e3 = ep[3];
        const float te = ((e0.x + e0.y) + (e0.z + e0.w)) + ((e1.x + e1.y) + (e1.z + e1.w)) + ((e2.x + e2.y) + (e2.z + e2.w)) + ((e3.x + e3.y) + (e3.z + e3.w));
        if (lane == 0) { RSTDE[m] = 1.f / sqrtf(te * (1.f / D) + EPS); RSTD2[m] = r1; }
        const f32x4* irow = (const f32x4*)(h1 + (size_t)m * D) + lane; const v2u* mr = (const v2u*)(MIX + (size_t)m * D) + lane; v2u* nrow = (v2u*)(XN + (size_t)m * D) + lane;
#pragma unroll
        for (int j = 0; j < 4; ++j) { const f32x4 hv0 = irow[64 * j]; const v2u mw = mr[64 * j]; const f32x4 mv = {bflo(mw.x), bfhi(mw.x), bflo(mw.y), bfhi(mw.y)};
            const f32x4 hv = hv0 + mv * r1 * gp[j]; v2u w; w.x = cvtpk(hv.x, hv.y); w.y = cvtpk(hv.z, hv.w); nrow[64 * j] = w; }
    }
}

__global__ void __launch_bounds__(NWAVES * 64, 2) fwd_megakernel(Args args) {
    extern __shared__ __attribute__((aligned(16))) unsigned char lds_raw[];
    LAS unsigned char* lds = (LAS unsigned char*)lds_raw;
    const int tid = threadIdx.x, lane = tid & 63, wave = __builtin_amdgcn_readfirstlane(tid >> 6);
    const int G = gridDim.x, gw = blockIdx.x * NWAVES + wave, NGW = G * NWAVES;
    unsigned char* ws = args.ws;
    bf16 *WinT = (bf16*)(ws + WS_WIN), *WpleT = (bf16*)(ws + WS_WPLE), *WoutT = (bf16*)(ws + WS_WOUT), *WupT = (bf16*)(ws + WS_WUP), *WdownT = (bf16*)(ws + WS_WDOWN), *WgateT = (bf16*)(ws + WS_WGATE);
    bf16 *XN = (bf16*)(ws + WS_XN), *PB = (bf16*)(ws + WS_PB), *PROJ = (bf16*)(ws + WS_PROJ), *VT = (bf16*)(ws + WS_VT), *MIXIN = (bf16*)(ws + WS_MIXIN), *ERAW = (bf16*)(ws + WS_ERAW),
         *MIX = (bf16*)(ws + WS_MIX), *ABUF = (bf16*)(ws + WS_A);
    float *SS1 = (float*)(ws + WS_SS1), *SS2 = (float*)(ws + WS_SS2), *SSE = (float*)(ws + WS_SSE), *RSTDE = (float*)(ws + WS_RSTDE), *RSTD2 = (float*)(ws + WS_RSTDE) + M;
    const int lo = args.ph_lo, hi = args.ph_hi;
    volatile LAS unsigned* MISC = (volatile LAS unsigned*)(lds + MISC_OFF);
    if (tid < 32) MISC[tid] = 0u;
    __syncthreads();
    XcdBarrier bar = xcd_barrier_post((unsigned*)(ws + WS_CTL), MISC + 8);
    if (hi > 1000) cg::this_grid().sync();
#define IN(k) (lo <= (k) && (k) < hi)
#define SEAM(k) do { if (IN(k) && IN((k) + 1)) xcd_barrier(bar); } while (0)

    if (IN(0)) { for (int rp = 0; rp < REP[0]; ++rp) { p0_prologue(args, lds, tid, lane, wave, G); __syncthreads(); } }
    SEAM(0);
    bool fast = false; int cdeal = (int)blockIdx.x;
    if (IN(0) && hi == N_PHASES) {
        if (tid == 0) { unsigned ok = (G == 256) ? 1u : 0u;
            for (unsigned j = 0; j < 16; ++j) { const unsigned c = xb_ld(&bar.bar[XB_XCNT(j)]); ok &= (j < 8) ? (c == 32u ? 1u : 0u) : (c == 0u ? 1u : 0u); }
            MISC[11] = ok; }
        __syncthreads();
        fast = __builtin_amdgcn_readfirstlane((int)MISC[11]) != 0;
        if (fast) cdeal = __builtin_amdgcn_readfirstlane((int)MISC[10]) * 8 + (int)bar.x;
    }
    const int rfirst = fast ? 2048 * (int)bar.x + (cdeal >> 3) * NWAVES + wave : gw, rend = fast ? 2048 * ((int)bar.x + 1) : M, rstep = fast ? 256 : NGW;
#define SEAML(k) do { if (IN(k) && IN((k) + 1)) { if (fast) xcd_barrier_local(bar); else xcd_barrier(bar); } } while (0)
    if (IN(1)) {
        const bool eraw_first = ((blockIdx.x >> 3) & 1) != 0;
        if (eraw_first) {
            pg8::Gemm g{PB, WpleT, M, D, PLE}; pg8::StaticOrder S; S.init(M, D, G, (int)blockIdx.x);
            pg8::EpiStore<0, true> E{ERAW, D, SSE};
            pg8::gemm_phase<pg8::EpiStore<0, true>, pg8::StaticOrder, PG8_ALIGN, PG8_SP2>(lds, g, S, E);
        }
        {
            pg8::Gemm g{XN, WinT, M, LDP, D}; pg8::StaticOrder S; S.init(M, LDP, G, (int)blockIdx.x);
            pg8::EpiStore<0, false> E{PROJ, LDP, nullptr};
            pg8::gemm_phase<pg8::EpiStore<0, false>, pg8::StaticOrder, PG8_ALIGN, PG8_SP2>(lds, g, S, E);
        }
        {
            pg8::Gemm g{WinT + (size_t)1536 * D, XN, 512, M, D}; pg8::StaticOrder S; S.init(512, M, G, (int)((blockIdx.x + G / 2) % G));
            pg8::EpiVT4 E{VT};
            pg8::gemm_phase<pg8::EpiVT4, pg8::StaticOrder, PG8_ALIGN, PG8_SP2>(lds, g, S, E);
        }
        if (!eraw_first) {
            pg8::Gemm g{PB, WpleT, M, D, PLE}; pg8::StaticOrder S; S.init(M, D, G, (int)blockIdx.x);
            pg8::EpiStore<0, true> E{ERAW, D, SSE};
            pg8::gemm_phase<pg8::EpiStore<0, true>, pg8::StaticOrder, PG8_ALIGN, PG8_SP2>(lds, g, S, E);
        }
    }
    SEAM(1);
    if (IN(2)) for (int rp = 0; rp < REP[2]; ++rp) {
        p2_pool(PROJ, MIXIN, blockIdx.x * 512 + tid, G * 512);
        const float* g_sb = args.in[6];
        constexpr int NU = BATCH * NH * (SEQ / 32); const int upw = (NU + G - 1) / G, ubeg = blockIdx.x * upw, uend = (ubeg + upw < NU) ? ubeg + upw : NU;
        if (wave >= 4) late_weights(args, lds, lane, wave, G);
        for (int u = ubeg + wave; u < uend; u += NWAVES) { const int qb = u & 255, bh = u >> 8, h = bh & 7, b = bh >> 3; sb_unit(PROJ, VT, g_sb, MIXIN, b, h, qb, lane); }
        if (wave < 4) late_weights(args, lds, lane, wave, G);
    }
    SEAM(2);
    if (IN(3)) for (int rp = 0; rp < REP[3]; ++rp) {
        pg8::Gemm g{MIXIN, WoutT, M, D, D}; pg8::StaticOrder S; S.init(M, D, G, cdeal);
        pg8::EpiStore<0, true> E{MIX, D, SS1};
        pg8::gemm_phase<pg8::EpiStore<0, true>, pg8::StaticOrder, PG8_ALIGN, PG8_SP2>(lds, g, S, E);
    }
    SEAML(3);
    if (IN(4)) for (int rp = 0; rp < REP[4]; ++rp) p4_rows(args.in[0], MIX, SS1, args.in[8], args.in[9], args.out, XN, rfirst, rend, rstep, lane);
    SEAML(4);
    if (IN(5)) for (int rp = 0; rp < REP[5]; ++rp) {
        pg8::Gemm g{XN, WupT, M, FF, D}; pg8::StaticOrder S; S.init(M, FF, G, cdeal);
        pg8::EpiStore<1, false> E{ABUF, FF, nullptr};
        pg8::gemm_phase<pg8::EpiStore<1, false>, pg8::StaticOrder, PG8_ALIGN, PG8_SP2>(lds, g, S, E);
    }
    SEAML(5);
    if (IN(6)) for (int rp = 0; rp < REP[6]; ++rp) {
        pg8::Gemm g{ABUF, WdownT, M, D, FF}; pg8::StaticOrder S; S.init(M, D, G, cdeal);
        pg8::EpiStore<0, true> E{MIX, D, SS2};
        pg8::gemm_phase<pg8::EpiStore<0, true>, pg8::StaticOrder, PG8_ALIGN, PG8_SP2>(lds, g, S, E);
    }
    SEAML(6);
    if (IN(7)) for (int rp = 0; rp < REP[7]; ++rp) p7_rows(MIX, SS2, SSE, args.in[12], args.out, XN, RSTDE, RSTD2, rfirst, rend, rstep, lane);
    SEAML(7);
    if (IN(8)) for (int rp = 0; rp < REP[8]; ++rp) {
        pg8::Gemm g{XN, WgateT, M, D, D}; pg8::StaticOrder S; S.init(M, D, G, cdeal);
        pg8::EpiFinal E{args.out, MIX, RSTD2, args.in[12], ERAW, RSTDE, args.in[15]};
        pg8::gemm_phase<pg8::EpiFinal, pg8::StaticOrder, PG8_ALIGN, PG8_SP2>(lds, g, S, E);
    }
#undef IN
#undef SEAM
#undef SEAML
}

extern "C" void kernel_launch(void* const* d_in, const int* in_sizes, int n_in, void* d_out, int out_size, void* d_ws, size_t ws_size, hipStream_t stream) {
    static int grid = 0;
    if (grid == 0) {
        if (n_in != 16 || in_sizes[0] != M * D || out_size != M * D || ws_size < WS_END) { fprintf(stderr, "kernel_launch: unexpected shapes (n_in %d, in0 %d, out %d, ws %zu)\n", n_in, n_in > 0 ? in_sizes[0] : -1, out_size, ws_size); grid = -1; return; }
        int dev = 0, cus = 0, per_cu = 0;
        if (hipGetDevice(&dev) != hipSuccess || hipDeviceGetAttribute(&cus, hipDeviceAttributeMultiprocessorCount, dev) != hipSuccess) { grid = -1; return; }
        if (hipFuncSetAttribute((const void*)fwd_megakernel, hipFuncAttributeMaxDynamicSharedMemorySize, LDS_BYTES) != hipSuccess) { fprintf(stderr, "kernel_launch: hipFuncSetAttribute failed\n"); grid = -1; return; }
        if (hipOccupancyMaxActiveBlocksPerMultiprocessor(&per_cu, (const void*)fwd_megakernel, NWAVES * 64, LDS_BYTES) != hipSuccess || per_cu < 1) { fprintf(stderr, "kernel_launch: occupancy query says %d\n", per_cu); per_cu = 1; }
        (void)hipGetLastError();
        grid = cus * per_cu;
    }
    if (grid < 0) return;
    if (hipMemsetAsync((char*)d_ws + WS_CTL, 0, CTL_ZERO_BYTES, stream) != hipSuccess) { fprintf(stderr, "kernel_launch: memset failed\n"); return; }
    Args a{};
    for (int i = 0; i < 16; ++i) a.in[i] = (const float*)d_in[i];
    a.out = (float*)d_out; a.ws = (unsigned char*)d_ws;
#if MK_MULTI
    for (int ph = 0; ph < N_PHASES; ++ph) { a.ph_lo = ph; a.ph_hi = ph + 1; hipLaunchKernelGGL(fwd_megakernel, dim3(grid), dim3(NWAVES * 64), LDS_BYTES, stream, a); }
#else
    a.ph_lo = 0; a.ph_hi = N_PHASES;
    void* kargs[] = {&a};
    hipError_t e = hipLaunchCooperativeKernel((const void*)fwd_megakernel, dim3(grid), dim3(NWAVES * 64), kargs, LDS_BYTES, stream);
    if (e != hipSuccess) fprintf(stderr, "cooperative launch failed: %s (grid %d)\n", hipGetErrorString(e), grid);
#endif
}
```

```cpp
#include <hip/hip_runtime.h>
#include <hip/hip_cooperative_groups.h>
#include <cstdio>
#include <cstdint>
namespace cg = cooperative_groups;
namespace pg8 {
#define PG8_LAS __attribute__((address_space(3)))
typedef unsigned short bf16_t;
typedef short bf16x8 __attribute__((ext_vector_type(8)));
typedef float f32x4 __attribute__((ext_vector_type(4)));
typedef unsigned u32x4 __attribute__((ext_vector_type(4)));
constexpr int BM = 256, BK = 64, HALF = 128, HTB = HALF * BK * 2  , STAGE_BYTES = 8 * HTB, NXCD = 8, WGM = 8;

__host__ __device__ __forceinline__ int lds_byte(int r, int c) { const int st = (r >> 4) * 2 + (c >> 5), rr = r & 15, cc = c & 31, ob = rr * 64 + cc * 2; return st * 1024 + (ob ^ (((ob >> 9) & 1) << 5)); }
__host__ __device__ __forceinline__ void stage_rc(int b, int& R, int& C) { const int st = b / 1024, sb = b % 1024, swz = sb ^ (((sb >> 9) & 1) << 5); R = (st >> 1) * 16 + swz / 64; C = (st & 1) * 32 + (swz % 64) / 2; }
__host__ __device__ __forceinline__ int perm32(int rho) { const int n = rho >> 4, i = rho & 15; return 8 * (i >> 2) + 4 * n + (i & 3); }

struct Unit { int pm, pn; };
struct Gemm { const bf16_t* A; const bf16_t* Bt; int M, N, K; };

struct StaticOrder {
    int nM, nN, nwg, G, c;
    __host__ __device__ void init(int M, int N, int G_, int c_) { nM = M / BM; nN = N / BM; nwg = nM * nN; G = G_; c = c_; }
    __host__ __device__ bool next(int i, Unit& u) const {
        const long L = (long)i * G + c; if (L >= nwg) return false;
        int wgid = (int)L; { const int q = nwg / NXCD, r = nwg % NXCD, xcd = wgid % NXCD, off = wgid / NXCD; wgid = (xcd < r ? xcd * (q + 1) : r * (q + 1) + (xcd - r) * q) + off; }
        const int nig = WGM * nN, gid = wgid / nig, fm = gid * WGM, gsz = (nM - fm) < WGM ? (nM - fm) : WGM;
        u.pm = fm + ((wgid % nig) % gsz); u.pn = (wgid % nig) / gsz; return true;
    }
    __device__ __forceinline__ void a_ready(const Unit&) const {}
    __device__ __forceinline__ void done(const Unit&) const {}
};

__device__ __forceinline__ unsigned cvt_pk_bf16(float lo, float hi) { unsigned r; asm volatile("v_cvt_pk_bf16_f32 %0, %1, %2" : "=v"(r) : "v"(lo), "v"(hi)); return r; }
typedef float f32x2 __attribute__((ext_vector_type(2)));
typedef float f32x2_t __attribute__((ext_vector_type(2)));
typedef unsigned u32x2 __attribute__((ext_vector_type(2)));
typedef __bf16 bf16x2_t __attribute__((ext_vector_type(2)));
__device__ __forceinline__ unsigned cvtpk(float lo, float hi) { f32x2_t v = {lo, hi}; bf16x2_t b = __builtin_convertvector(v, bf16x2_t); return __builtin_bit_cast(unsigned, b); }
__device__ __forceinline__ float bflo(unsigned w) { return __builtin_bit_cast(float, w << 16); }
__device__ __forceinline__ float bfhi(unsigned w) { return __builtin_bit_cast(float, w & 0xffff0000u); }

template <int ACT, bool SS> struct EpiStore {
    static constexpr bool PERM = true, AFTER_DRAIN = false;
    bf16_t* O; int ldc; float* ss;
    __device__ __forceinline__ void operator()(const f32x4 (&acc)[2][2][4][2], const Unit& u, int wr, int wc, int fr, int fq) const {
        const int row0 = u.pm * BM + wr * 64 + fr, col0 = u.pn * BM + wc * 32 + 8 * fq;
#pragma unroll
        for (int ai = 0; ai < 2; ++ai)
#pragma unroll
            for (int m = 0; m < 4; ++m) { const int row = row0 + ai * HALF + m * 16; bf16_t* rowp = O + (size_t)row * ldc + col0; float s = 0.f;
#pragma unroll
                for (int bj = 0; bj < 2; ++bj) { f32x4 v0 = acc[ai][bj][m][0], v1 = acc[ai][bj][m][1];
                    if (ACT == 1) {
#pragma unroll
                        for (int e = 0; e < 4; ++e) { const float a = fmaxf(v0[e], 0.f), b = fmaxf(v1[e], 0.f); v0[e] = a * a; v1[e] = b * b; } }
                    if (SS) s += (v0[0] * v0[0] + v0[1] * v0[1]) + (v0[2] * v0[2] + v0[3] * v0[3]) + (v1[0] * v1[0] + v1[1] * v1[1]) + (v1[2] * v1[2] + v1[3] * v1[3]);
                    u32x4 w; w.x = cvtpk(v0[0], v0[1]); w.y = cvtpk(v0[2], v0[3]); w.z = cvtpk(v1[0], v1[1]); w.w = cvtpk(v1[2], v1[3]);
                    *(u32x4*)(rowp + bj * HALF) = w; }
                if (SS) { s += __shfl_xor(s, 16); s += __shfl_xor(s, 32); if (fq == 0) ss[(size_t)row * 16 + u.pn * 4 + wc] = s; } }
    }
};
struct EpiVT4 {
    static constexpr bool PERM = true, AFTER_DRAIN = false;
    bf16_t* O;
    __device__ __forceinline__ void operator()(const f32x4 (&acc)[2][2][4][2], const Unit& u, int wr, int wc, int fr, int fq) const {
        const int row0 = u.pm * BM + wr * 64 + fr, col0 = u.pn * BM + wc * 32 + 8 * fq;
#pragma unroll
        for (int ai = 0; ai < 2; ++ai)
#pragma unroll
            for (int m = 0; m < 4; ++m) { const int row = row0 + ai * HALF + m * 16, h = row >> 6, d = row & 63;
#pragma unroll
                for (int bj = 0; bj < 2; ++bj) { const int tok = col0 + bj * HALF, b = tok >> 13, tok4 = (tok & 8191) >> 2;
                    bf16_t* dst = O + (((size_t)(b * 8 + h) * 2048 + tok4) * 64 + d) * 4;
                    const f32x4 v0 = acc[ai][bj][m][0], v1 = acc[ai][bj][m][1];
                    u32x2 w0, w1; w0.x = cvtpk(v0[0], v0[1]); w0.y = cvtpk(v0[2], v0[3]); w1.x = cvtpk(v1[0], v1[1]); w1.y = cvtpk(v1[2], v1[3]);
                    *(u32x2*)dst = w0; *(u32x2*)(dst + 256) = w1; } }
    }
};
struct EpiFinal {
    static constexpr bool PERM = true, AFTER_DRAIN = false;
    float* out; const bf16_t* mix; const float* r2; const float* gpost; const bf16_t* eraw; const float* rstd_e; const float* g;
    __device__ __forceinline__ void operator()(const f32x4 (&acc)[2][2][4][2], const Unit& u, int wr, int wc, int fr, int fq) const {
        const int row0 = u.pm * BM + wr * 64 + fr, col0 = u.pn * BM + wc * 32 + 8 * fq;
        f32x4 gv[2][2], gp[2][2];
#pragma unroll
        for (int bj = 0; bj < 2; ++bj) { gv[bj][0] = *(const f32x4*)(g + col0 + bj * HALF); gv[bj][1] = *(const f32x4*)(g + col0 + bj * HALF + 4);
            gp[bj][0] = *(const f32x4*)(gpost + col0 + bj * HALF); gp[bj][1] = *(const f32x4*)(gpost + col0 + bj * HALF + 4); }
#pragma unroll
        for (int ai = 0; ai < 2; ++ai)
#pragma unroll
            for (int m = 0; m < 4; ++m) { const int row = row0 + ai * HALF + m * 16; const float re = rstd_e[row], rm = r2[row];
#pragma unroll
                for (int bj = 0; bj < 2; ++bj) { float* op = out + (size_t)row * 1024 + col0 + bj * HALF;
                    const f32x4 h0 = *(const f32x4*)op, h1 = *(const f32x4*)(op + 4);
                    const u32x4 ew = *(const u32x4*)(eraw + (size_t)row * 1024 + col0 + bj * HALF), mw = *(const u32x4*)(mix + (size_t)row * 1024 + col0 + bj * HALF);
                    const f32x4 e0 = {bflo(ew.x), bfhi(ew.x), bflo(ew.y), bfhi(ew.y)}, e1 = {bflo(ew.z), bfhi(ew.z), bflo(ew.w), bfhi(ew.w)};
                    const f32x4 m0 = {bflo(mw.x), bfhi(mw.x), bflo(mw.y), bfhi(mw.y)}, m1 = {bflo(mw.z), bfhi(mw.z), bflo(mw.w), bfhi(mw.w)};
                    f32x4 o0, o1;
#pragma unroll
                    for (int e = 0; e < 4; ++e) {
                        const float g0 = __builtin_amdgcn_rcpf(1.f + __builtin_amdgcn_exp2f(acc[ai][bj][m][0][e] * -1.4426950408889634f));
                        const float g1 = __builtin_amdgcn_rcpf(1.f + __builtin_amdgcn_exp2f(acc[ai][bj][m][1][e] * -1.4426950408889634f));
                        o0[e] = (h0[e] + m0[e] * rm * gp[bj][0][e]) + g0 * (e0[e] * re * gv[bj][0][e]); o1[e] = (h1[e] + m1[e] * rm * gp[bj][1][e]) + g1 * (e1[e] * re * gv[bj][1][e]); }
                    *(f32x4*)op = o0; *(f32x4*)(op + 4) = o1; }
                asm volatile("" ::: "memory"); }
    }
};
template <class Epi, class Sched, bool ALIGN_EPI = false, bool SP2 = false>
__device__ __forceinline__ void gemm_phase(PG8_LAS unsigned char* lds, const Gemm g, const Sched& S, const Epi& E) {
    const int tid = threadIdx.x, wid = __builtin_amdgcn_readfirstlane(tid >> 6), lane = tid & 63, wr = wid >> 2, wc = wid & 3, fr = lane & 15, fq = lane >> 4;
    const int K = g.K, nt = K / BK;
    unsigned voffA[2], voffB[2];
#pragma unroll
    for (int i = 0; i < 2; ++i) { int R, C; stage_rc(tid * 16 + i * 8192, R, C); const int Rb = Epi::PERM ? ((R & ~31) + perm32(R & 31)) : R;
        voffA[i] = (unsigned)(R * K + C) * 2u; voffB[i] = (unsigned)(Rb * K + C) * 2u; }
    const size_t kstep = (size_t)(BK * 2);
    const size_t hstep = (size_t)HALF * K * 2;
    const size_t tstep = 2 * hstep;
    const unsigned ldsw = (unsigned)wid * 1024u;
    const int aoff = lds_byte(wr * 64 + fr, fq * 8), boff = lds_byte(wc * 32 + fr, fq * 8);
#define PG8_SA(b, h) (((b) * 2 + (h)) * HTB)
#define PG8_SB(b, h) ((4 + (b) * 2 + (h)) * HTB)
#define PG8_STAGE(bufoff, gbase, voff) do { _Pragma("unroll") for (int _i = 0; _i < 2; ++_i) \
        __builtin_amdgcn_global_load_lds((const unsigned*)((const char*)(gbase) + (voff)[_i]), (PG8_LAS unsigned*)(lds + (bufoff) + ldsw + _i * 8192), 16, 0, 0); } while (0)
#define PG8_LDA(dst, b, h) do { _Pragma("unroll") for (int m = 0; m < 4; ++m) _Pragma("unroll") for (int k = 0; k < 2; ++k) dst[m][k] = *(const PG8_LAS bf16x8*)(lds + PG8_SA(b, h) + aoff + m * 2048 + k * 1024); } while (0)
#define PG8_LDB(dst, b, h) do { _Pragma("unroll") for (int n = 0; n < 2; ++n) _Pragma("unroll") for (int k = 0; k < 2; ++k) dst[n][k] = *(const PG8_LAS bf16x8*)(lds + PG8_SB(b, h) + boff + n * 2048 + k * 1024); } while (0)
#define PG8_MMA(ai, bj, At, Bt) do { __builtin_amdgcn_s_setprio(1); _Pragma("unroll") for (int m = 0; m < 4; ++m) _Pragma("unroll") for (int n = 0; n < 2; ++n) _Pragma("unroll") for (int k = 0; k < 2; ++k) \
        acc[ai][bj][m][n] = __builtin_amdgcn_mfma_f32_16x16x32_bf16(Bt[n][k], At[m][k], acc[ai][bj][m][n], 0, 0, 0); __builtin_amdgcn_s_setprio(0); } while (0)
#define PG8_WAIT_V(n) asm volatile("s_waitcnt vmcnt(" #n ")" ::: "memory")
#define PG8_WAIT_L(n) asm volatile("s_waitcnt lgkmcnt(" #n ")" ::: "memory")
#define PG8_BAR __builtin_amdgcn_s_barrier()
#define PG8_SCHED __builtin_amdgcn_sched_barrier(0)
    Unit cur, nxt; int ui = 0;
    if (!S.next(0, cur)) return;
    f32x4 acc[2][2][4][2];
#pragma unroll
    for (int a = 0; a < 2; ++a)
#pragma unroll
        for (int b = 0; b < 2; ++b)
#pragma unroll
            for (int m = 0; m < 4; ++m)
#pragma unroll
                for (int n = 0; n < 2; ++n) acc[a][b][m][n] = (f32x4){0.f, 0.f, 0.f, 0.f};
    bf16x8 At[4][2], B0[2][2], B1[2][2];
    const char* cA = (const char*)g.A + (size_t)cur.pm * tstep; const char* cB = (const char*)g.Bt + (size_t)cur.pn * tstep;
    S.a_ready(cur);
    if constexpr (SP2) {
        PG8_STAGE(PG8_SB(0, 0), cB, voffB); PG8_STAGE(PG8_SB(0, 1), cB + hstep, voffB); PG8_STAGE(PG8_SA(0, 0), cA, voffA); PG8_STAGE(PG8_SA(0, 1), cA + hstep, voffA);
        if (wr == 1) PG8_BAR;
        PG8_WAIT_V(2); PG8_BAR;
        PG8_STAGE(PG8_SB(1, 0), cB + kstep, voffB); PG8_STAGE(PG8_SA(1, 0), cA + kstep, voffA); PG8_STAGE(PG8_SB(1, 1), cB + hstep + kstep, voffB);
        PG8_WAIT_V(6); PG8_BAR;
    } else {
        PG8_STAGE(PG8_SB(0, 0), cB, voffB); PG8_STAGE(PG8_SA(0, 0), cA, voffA); PG8_STAGE(PG8_SB(0, 1), cB + hstep, voffB); PG8_STAGE(PG8_SA(0, 1), cA + hstep, voffA);
        if (wr == 1) PG8_BAR;
        PG8_WAIT_V(4); PG8_BAR;
        PG8_STAGE(PG8_SB(1, 0), cB + kstep, voffB); PG8_STAGE(PG8_SA(1, 0), cA + kstep, voffA); PG8_STAGE(PG8_SB(1, 1), cB + hstep + kstep, voffB);
        PG8_WAIT_V(6); PG8_BAR;
    }
    for (;;) {
        const bool has_next = S.next(ui + 1, nxt);
        const char* nA = has_next ? (const char*)g.A + (size_t)nxt.pm * tstep : cA; const char* nB = has_next ? (const char*)g.Bt + (size_t)nxt.pn * tstep : cB;
        for (int t = 0; t < nt; t += 2) {
            const bool last = (t == nt - 2);
            const char* a1 = cA + (size_t)(t + 1) * kstep;
            const char* a2 = last ? nA : cA + (size_t)(t + 2) * kstep; const char* b2 = last ? nB : cB + (size_t)(t + 2) * kstep;
            const char* a3 = a2 + kstep; const char* b3 = b2 + kstep;
            if (last && has_next) S.a_ready(nxt);
            if constexpr (SP2) {
            PG8_LDB(B0, 0, 0); PG8_LDB(B1, 0, 1); PG8_SCHED; PG8_LDA(At, 0, 0); PG8_STAGE(PG8_SA(1, 1), a1 + hstep, voffA);
            PG8_WAIT_V(8); PG8_WAIT_L(0); PG8_BAR; PG8_MMA(0, 0, At, B0); PG8_MMA(0, 1, At, B1); PG8_BAR; PG8_SCHED;
            PG8_LDA(At, 0, 1); PG8_STAGE(PG8_SB(0, 0), b2, voffB); PG8_STAGE(PG8_SB(0, 1), b2 + hstep, voffB); PG8_STAGE(PG8_SA(0, 0), a2, voffA);
            PG8_WAIT_V(8); PG8_WAIT_L(0); PG8_BAR; PG8_MMA(1, 0, At, B0); PG8_MMA(1, 1, At, B1); PG8_BAR; PG8_SCHED;
            PG8_LDB(B0, 1, 0); PG8_LDB(B1, 1, 1); PG8_SCHED; PG8_LDA(At, 1, 0); PG8_STAGE(PG8_SA(0, 1), a2 + hstep, voffA);
            PG8_WAIT_V(8); PG8_WAIT_L(0); PG8_BAR; PG8_MMA(0, 0, At, B0); PG8_MMA(0, 1, At, B1); PG8_BAR; PG8_SCHED;
            PG8_LDA(At, 1, 1); PG8_STAGE(PG8_SB(1, 0), b3, voffB); PG8_STAGE(PG8_SB(1, 1), b3 + hstep, voffB); PG8_STAGE(PG8_SA(1, 0), a3, voffA);
            PG8_WAIT_V(8); PG8_WAIT_L(0); PG8_BAR; PG8_MMA(1, 0, At, B0); PG8_MMA(1, 1, At, B1); PG8_BAR; PG8_SCHED;
            } else {
            PG8_LDB(B0, 0, 0); PG8_SCHED; PG8_LDA(At, 0, 0); PG8_STAGE(PG8_SA(1, 1), a1 + hstep, voffA);
            PG8_WAIT_L(8); PG8_BAR; PG8_WAIT_L(0); PG8_MMA(0, 0, At, B0); PG8_BAR; PG8_SCHED;
            PG8_LDB(B1, 0, 1); PG8_STAGE(PG8_SB(0, 0), b2, voffB);
            PG8_BAR; PG8_WAIT_L(0); PG8_MMA(0, 1, At, B1); PG8_BAR;
            PG8_LDA(At, 0, 1); PG8_STAGE(PG8_SA(0, 0), a2, voffA);
            PG8_BAR; PG8_WAIT_L(0); PG8_MMA(1, 0, At, B0); PG8_BAR; PG8_SCHED;
            PG8_STAGE(PG8_SB(0, 1), b2 + hstep, voffB);
            PG8_WAIT_V(6); PG8_BAR; PG8_MMA(1, 1, At, B1); PG8_BAR;
            PG8_LDB(B0, 1, 0); PG8_SCHED; PG8_LDA(At, 1, 0); PG8_STAGE(PG8_SA(0, 1), a2 + hstep, voffA);
            PG8_WAIT_L(8); PG8_BAR; PG8_WAIT_L(0); PG8_MMA(0, 0, At, B0); PG8_BAR; PG8_SCHED;
            PG8_LDB(B1, 1, 1); PG8_STAGE(PG8_SB(1, 0), b3, voffB);
            PG8_BAR; PG8_WAIT_L(0); PG8_MMA(0, 1, At, B1); PG8_BAR;
            PG8_LDA(At, 1, 1); PG8_STAGE(PG8_SA(1, 0), a3, voffA);
            PG8_BAR; PG8_WAIT_L(0); PG8_MMA(1, 0, At, B0); PG8_BAR; PG8_SCHED;
            PG8_STAGE(PG8_SB(1, 1), b3 + hstep, voffB);
            PG8_WAIT_V(6); PG8_BAR; PG8_MMA(1, 1, At, B1); PG8_BAR;
            }
        }
        if constexpr (ALIGN_EPI) { if (wr == 0) PG8_BAR; }
        if constexpr (!Epi::AFTER_DRAIN) { E(acc, cur, wr, wc, fr, fq); S.done(cur); }
        if (!has_next) break;
#pragma unroll
        for (int a = 0; a < 2; ++a)
#pragma unroll
            for (int b = 0; b < 2; ++b)
#pragma unroll
                for (int m = 0; m < 4; ++m)
#pragma unroll
                    for (int n = 0; n < 2; ++n) acc[a][b][m][n] = (f32x4){0.f, 0.f, 0.f, 0.f};
        cur = nxt; cA = nA; cB = nB; ++ui;
        if constexpr (ALIGN_EPI) { if (wr == 1) PG8_BAR; }
    }
    PG8_WAIT_V(0);
    if constexpr (!ALIGN_EPI) { if (wr == 0) PG8_BAR; }
    PG8_BAR;
    if constexpr (Epi::AFTER_DRAIN) { E.fused(acc, cur, wr, wc, fr, fq, lds, wid, lane); S.done(cur); }
#undef PG8_SA
#undef PG8_SB
#undef PG8_STAGE
#undef PG8_LDA
#undef PG8_LDB
#undef PG8_MMA
#undef PG8_WAIT_V
#undef PG8_WAIT_L
#undef PG8_BAR
#undef PG8_SCHED
}
}
#ifndef PG8_SP2
#define PG8_SP2 true
#endif
#ifndef PG8_ALIGN
#define PG8_ALIGN true
#endif
#ifndef REPV
#define REPV {1,1,1,1,1,1,1,1,1}
#endif
constexpr int REP[9] = REPV;
#ifndef REP1V
#define REP1V {1,1,1}
#endif
constexpr int REP1[3] = REP1V;
#ifndef MK_MULTI
#define MK_MULTI 0
#endif
constexpr int NWAVES = 8;
constexpr int BATCH = 2, SEQ = 8192, D = 1024, FF = 4096, PLE = 256, NH = 8, HD = 64;
constexpr int M = BATCH * SEQ;
constexpr int LDP = 1536;
constexpr float EPS = 1e-6f;
constexpr int N_PHASES = 9;
constexpr size_t MiB = 1u << 20;
constexpr size_t WS_CTL = 0, CTL_ZERO_BYTES = 65536;
constexpr size_t WS_WIN = 1 * MiB, WS_WPLE = 5 * MiB, WS_WOUT = 6 * MiB, WS_WUP = 8 * MiB, WS_WDOWN = 16 * MiB, WS_WGATE = 24 * MiB;
constexpr size_t WS_SS1 = 26 * MiB, WS_SS2 = 27 * MiB, WS_SSE = 28 * MiB, WS_RSTDE = 29 * MiB;
constexpr size_t WS_A = 32 * MiB;
constexpr size_t WS_PROJ = 32 * MiB, WS_VT = 80 * MiB, WS_PB = 128 * MiB;
constexpr size_t WS_XN = 160 * MiB, WS_ERAW = 192 * MiB, WS_MIX = 224 * MiB, WS_END = 256 * MiB;
constexpr size_t WS_MIXIN = WS_XN;
constexpr int RING_BYTES = 131072, MISC_OFF = RING_BYTES + 320, LDS_BYTES = 147456;

#define GAS __attribute__((address_space(1)))
#define LAS __attribute__((address_space(3)))
typedef unsigned short bf16;
typedef unsigned v4u __attribute__((ext_vector_type(4)));
typedef unsigned v2u __attribute__((ext_vector_type(2)));
typedef float f32x4 __attribute__((ext_vector_type(4)));
typedef float f32x16 __attribute__((ext_vector_type(16)));
typedef short bf16x8 __attribute__((ext_vector_type(8)));
typedef short s16x4 __attribute__((ext_vector_type(4)));
using pg8::cvtpk; using pg8::bflo; using pg8::bfhi;
#define LDS_WAIT() asm volatile("s_waitcnt lgkmcnt(0)" ::: "memory")
#define XB_TMO      128
#define XB_XCNT(j)  (256  + 64 * (j))
#define XB_XSUB(j)  (1280 + 64 * (j))
#define XB_XGEN(j)  (2304 + 64 * (j))
#define XB_TOP      3328
#define XB_TOPGEN   3392
#define XCD_BAR_WORDS 3456
#define XB_SPIN_CAP (1u << 18)

__device__ __forceinline__ unsigned xb_ld(unsigned* p)              { return __hip_atomic_load(p, __ATOMIC_RELAXED, __HIP_MEMORY_SCOPE_AGENT); }
__device__ __forceinline__ unsigned xb_add(unsigned* p, unsigned v) { return __hip_atomic_fetch_add(p, v, __ATOMIC_RELAXED, __HIP_MEMORY_SCOPE_AGENT); }
__device__ __forceinline__ unsigned xb_xcc_id() { return (unsigned)__builtin_amdgcn_s_getreg((3 << 11) | 20) & 0xFu; }
#define XB_SPIN(cond, bar) do { unsigned _sp = 0; while (cond) { __builtin_amdgcn_s_sleep(1); \
    if ((++_sp & 255u) == 0u) { if (xb_ld(&(bar)[XB_TMO])) break; if (_sp > XB_SPIN_CAP) { atomicAdd(&(bar)[XB_TMO], 1u); break; } } } } while (0)

struct XcdBarrier {
    unsigned* bar; unsigned x;
    volatile LAS unsigned* st;
};

__device__ __forceinline__ XcdBarrier xcd_barrier_post(unsigned* bar, volatile LAS unsigned* st) {
    XcdBarrier b; b.bar = bar; b.x = xb_xcc_id(); b.st = st;
    if (threadIdx.x == 0) st[2] = xb_add(&bar[XB_XCNT(b.x)], 1u);
    return b;
}
__device__ __forceinline__ void xcd_barrier_complete(unsigned* bar, unsigned x, unsigned& nloc, unsigned& nx) {
    const unsigned G = gridDim.x * gridDim.y * gridDim.z;
    unsigned sum, cnt, mine, sp = 0u;
    for (;;) {
        sum = 0u; cnt = 0u; mine = 0u;
#pragma unroll
        for (unsigned j = 0; j < 16; ++j) { const unsigned c = xb_ld(&bar[XB_XCNT(j)]); sum += c; cnt += (c > 0u) ? 1u : 0u; mine = (j == x) ? c : mine; }
        if (sum == G) break;
        __builtin_amdgcn_s_sleep(1);
        if ((++sp & 255u) == 0u) { if (xb_ld(&bar[XB_TMO])) break; if (sp > XB_SPIN_CAP) { atomicAdd(&bar[XB_TMO], 1u); break; } }
    }
    nloc = mine > 0u ? mine : 1u; nx = cnt > 0u ? cnt : 1u;
}

__device__ __forceinline__ void xcd_barrier(const XcdBarrier& b) {
    asm volatile("s_waitcnt vmcnt(0)" ::: "memory");
    __syncthreads();
    if (threadIdx.x == 0) {
        unsigned* bar = b.bar;
        __builtin_amdgcn_s_waitcnt(0);
        unsigned nloc = b.st[0], nx = b.st[1];
        if (nloc == 0u) { xcd_barrier_complete(bar, b.x, nloc, nx); b.st[0] = nloc; b.st[1] = nx; }
        const unsigned old = xb_add(&bar[XB_XSUB(b.x)], 1u);
        const unsigned gen = old / nloc;
        if (old + 1u == (gen + 1u) * nloc) {
            __builtin_amdgcn_fence(__ATOMIC_RELEASE, "agent");
            asm volatile("s_waitcnt vmcnt(0)" ::: "memory");
            const unsigned og = xb_add(&bar[XB_TOP], 1u);
            const unsigned tg = og / nx;
            if (og + 1u == (tg + 1u) * nx) xb_add(&bar[XB_TOPGEN], 1u);
            else XB_SPIN(xb_ld(&bar[XB_TOPGEN]) == tg, bar);
            __builtin_amdgcn_fence(__ATOMIC_ACQUIRE, "agent");
            xb_add(&bar[XB_XGEN(b.x)], 1u);
            asm volatile("s_waitcnt vmcnt(0)" ::: "memory");
        } else {
            XB_SPIN(xb_ld(&bar[XB_XGEN(b.x)]) == gen, bar);
            __builtin_amdgcn_fence(__ATOMIC_ACQUIRE, "agent");
            asm volatile("s_waitcnt vmcnt(0)" ::: "memory");
        }
    }
    __syncthreads();
}

__device__ __forceinline__ void xcd_barrier_local(const XcdBarrier& b) {
    asm volatile("s_waitcnt vmcnt(0)" ::: "memory");
    __syncthreads();
    if (threadIdx.x == 0) {
        unsigned* bar = b.bar;
        __builtin_amdgcn_s_waitcnt(0);
        const unsigned nloc = b.st[0];
        const unsigned old = xb_add(&bar[XB_XSUB(b.x)], 1u);
        const unsigned gen = old / nloc;
        if (old + 1u == (gen + 1u) * nloc) xb_add(&bar[XB_XGEN(b.x)], 1u);
        else XB_SPIN(xb_ld(&bar[XB_XGEN(b.x)]) == gen, bar);
        __builtin_amdgcn_fence(__ATOMIC_ACQUIRE, "agent");
        asm volatile("s_waitcnt vmcnt(0)" ::: "memory");
    }
    __syncthreads();
}


struct Args { const float* in[16]; float* out; unsigned char* ws; int ph_lo, ph_hi; };
#define AS4 __attribute__((address_space(4)))
typedef const unsigned char AS4* kargp_t;
__device__ __forceinline__ kargp_t karg_fresh() { kargp_t p = (kargp_t)__builtin_amdgcn_kernarg_segment_ptr(); asm volatile("" : "+s"(p)); return p; }
template <class T> __device__ __forceinline__ T karg(kargp_t p, int off) { return *(const T AS4*)(p + off); }
#define KIN(p, i) karg<const float*>((p), 8 * (i))
#define KOUT(p) karg<float*>((p), 128)
#define KWS(p) karg<unsigned char*>((p), 136)
static_assert(sizeof(Args) == 152, "Args layout");

__device__ __forceinline__ float wave_sum(float v) {
#pragma unroll
    for (int o = 1; o < 64; o <<= 1) v += __shfl_xor(v, o);
    return v;
}
__device__ __forceinline__ void p0_transpose_item(const float* W, int N, bf16* WT, int ldwt, int coff, LAS float* scr, int kb, int nb, int lane) {
    const int k0 = 64 * kb, n0 = 32 * nb;
#pragma unroll 8
    for (int i = 0; i < 32; ++i) { const int kk = 2 * i + (lane >> 5); scr[kk * 33 + (lane & 31)] = W[(size_t)(k0 + kk) * N + n0 + (lane & 31)]; }
    LDS_WAIT(); asm volatile("" ::: "memory");
    const int c = lane & 7;
#pragma unroll
    for (int j = 0; j < 4; ++j) { const int n = (lane >> 3) + 8 * j; const LAS float* s = scr + (8 * c) * 33 + n;
        v4u o; o.x = cvtpk(s[0 * 33], s[1 * 33]); o.y = cvtpk(s[2 * 33], s[3 * 33]); o.z = cvtpk(s[4 * 33], s[5 * 33]); o.w = cvtpk(s[6 * 33], s[7 * 33]);
        *(v4u*)(WT + (size_t)(n0 + n) * ldwt + coff + k0 + 8 * c) = o; }
    LDS_WAIT(); asm volatile("" ::: "memory");
}

__device__ __forceinline__ void p0_prologue(kargp_t kp, LAS unsigned char* lds, int tid, int lane, int wave, int G) {
    unsigned char* ws = KWS(kp);
    const float *x = KIN(kp, 0), *p = KIN(kp, 1), *g_pre = KIN(kp, 2), *w_in = KIN(kp, 3), *w_pool = KIN(kp, 4), *pool_scale = KIN(kp, 5), *w_out = KIN(kp, 7), *w_ple = KIN(kp, 14);
    bf16 *WinT = (bf16*)(ws + WS_WIN), *WpleT = (bf16*)(ws + WS_WPLE), *WoutT = (bf16*)(ws + WS_WOUT);
    bf16 *XN = (bf16*)(ws + WS_XN), *PB = (bf16*)(ws + WS_PB);
    for (int item = blockIdx.x; item < 128; item += G) {
        const int g = item >> 5, n0 = (item & 31) * 32;
        LAS float* wps = (LAS float*)lds;
        LAS float* wo = (LAS float*)(lds + 128 * 129 * 4);
        for (int i = 0; i < 32; ++i) { const int idx = i * 512 + tid, c = idx >> 7, d = idx & 127; wps[c * 129 + d] = w_pool[(size_t)g * 16384 + idx] * pool_scale[g * 128 + d]; }
        for (int i = 0; i < 8; ++i) { const int idx = i * 512 + tid, d = idx >> 5, nn = idx & 31; wo[idx] = w_out[(size_t)(g * 128 + d) * 1024 + n0 + nn]; }
        __syncthreads();
        const int c = tid & 127, nq = tid >> 7;
        float acc[8];
#pragma unroll
        for (int j = 0; j < 8; ++j) acc[j] = 0.f;
#pragma unroll 4
        for (int d = 0; d < 128; ++d) { const float av = wps[c * 129 + d]; const f32x4 b0 = *(const LAS f32x4*)(wo + d * 32 + nq * 8), b1 = *(const LAS f32x4*)(wo + d * 32 + nq * 8 + 4);
#pragma unroll
            for (int j = 0; j < 4; ++j) { acc[j] += av * b0[j]; acc[4 + j] += av * b1[j]; } }
#pragma unroll
        for (int j = 0; j < 8; ++j) WoutT[(size_t)(n0 + nq * 8 + j) * 1024 + g * 128 + c] = (bf16)(cvtpk(acc[j], 0.f) & 0xffffu);
        __syncthreads();
    }
    LAS float* scr = (LAS float*)(lds + wave * 16384);
    const int gw = blockIdx.x * NWAVES + wave, NGW = G * NWAVES;
    {
        constexpr int I_IN = 16 * 64, I_PLE = 4 * 32, NITEMS = I_IN + I_PLE;
        for (int it = gw; it < NITEMS; it += NGW) {
            int r = it;
            if (r < I_IN) { p0_transpose_item(w_in, 2048, WinT, 1024, 0, scr, r / 64, r % 64, lane); continue; } r -= I_IN;
            p0_transpose_item(w_ple, 1024, WpleT, 256, 0, scr, r / 32, r % 32, lane);
        }
    }
    {
        f32x4 gv[4];
#pragma unroll
        for (int j = 0; j < 4; ++j) gv[j] = *(const f32x4*)(g_pre + 4 * lane + 256 * j);
        for (int m = gw; m < M; m += NGW) {
            const f32x4* xr = (const f32x4*)(x + (size_t)m * D) + lane; f32x4 v[4]; float s = 0.f;
#pragma unroll
            for (int j = 0; j < 4; ++j) { v[j] = xr[64 * j]; s += (v[j].x * v[j].x + v[j].y * v[j].y) + (v[j].z * v[j].z + v[j].w * v[j].w); }
            const float rstd = 1.f / sqrtf(wave_sum(s) * (1.f / D) + EPS);
            v2u* o8 = (v2u*)(XN + (size_t)m * D) + lane;
#pragma unroll
            for (int j = 0; j < 4; ++j) { const f32x4 y = v[j] * rstd * gv[j]; v2u w; w.x = cvtpk(y.x, y.y); w.y = cvtpk(y.z, y.w); o8[64 * j] = w; }
        }
    }
    for (size_t i = (size_t)gw * 64 + lane; i < (size_t)M * PLE / 8; i += (size_t)NGW * 64) {
        const f32x4 a0 = *(const f32x4*)(p + i * 8), a1 = *(const f32x4*)(p + i * 8 + 4);
        v4u w; w.x = cvtpk(a0.x, a0.y); w.y = cvtpk(a0.z, a0.w); w.z = cvtpk(a1.x, a1.y); w.w = cvtpk(a1.z, a1.w);
        *(v4u*)(PB + i * 8) = w;
    }
}

__device__ __forceinline__ void late_weights(kargp_t kp, LAS unsigned char* lds, int lane, int wave, int G) {
    unsigned char* ws = KWS(kp);
    const float *w_out = KIN(kp, 7), *w_up = KIN(kp, 10), *w_down = KIN(kp, 11), *w_gate = KIN(kp, 13);
    bf16 *WoutT = (bf16*)(ws + WS_WOUT), *WupT = (bf16*)(ws + WS_WUP), *WdownT = (bf16*)(ws + WS_WDOWN), *WgateT = (bf16*)(ws + WS_WGATE);
    LAS float* scr = (LAS float*)(lds + wave * 16384);
    const int gw = blockIdx.x * NWAVES + wave, NGW = G * NWAVES;
    constexpr int I_OUT = 8 * 32, I_UP = 16 * 128, I_DOWN = 64 * 32, I_GATE = 16 * 32, NITEMS = I_OUT + I_UP + I_DOWN + I_GATE;
    for (int it = gw; it < NITEMS; it += NGW) {
        int r = it;
        if (r < I_OUT) { p0_transpose_item(w_out + (size_t)512 * 1024, 1024, WoutT, 1024, 512, scr, r / 32, r % 32, lane); continue; } r -= I_OUT;
        if (r < I_UP) { p0_transpose_item(w_up, 4096, WupT, 1024, 0, scr, r / 128, r % 128, lane); continue; } r -= I_UP;
        if (r < I_DOWN) { p0_transpose_item(w_down, 1024, WdownT, 4096, 0, scr, r / 32, r % 32, lane); continue; } r -= I_DOWN;
        p0_transpose_item(w_gate, 1024, WgateT, 1024, 0, scr, r / 32, r % 32, lane);
    }
}

__device__ __forceinline__ void pool_acc(float (&s)[8], const v4u v, const float m) {
    s[0] += m * bflo(v.x); s[1] += m * bfhi(v.x); s[2] += m * bflo(v.y); s[3] += m * bfhi(v.y); s[4] += m * bflo(v.z); s[5] += m * bfhi(v.z); s[6] += m * bflo(v.w); s[7] += m * bfhi(v.w);
}
template <int W> __device__ __forceinline__ void pool_item(const bf16* PROJ, bf16* MIXIN, int m0, int col) {
    const int t0 = m0 & (SEQ - 1);
    const bf16* up = PROJ + (size_t)m0 * LDP + col;
    v4u v[W + 7];
#pragma unroll
    for (int j = 0; j < W + 7; ++j) { const int dr = j - (W - 1); const int drc = (t0 + dr < 0) ? -t0 : dr; v[j] = *(const v4u*)(up + (ptrdiff_t)drc * LDP); }
    float s[8];
#pragma unroll
    for (int e = 0; e < 8; ++e) s[e] = 0.f;
#pragma unroll
    for (int j = 0; j < W - 1; ++j) pool_acc(s, v[j], (t0 + j - (W - 1) >= 0) ? 1.f : 0.f);
#pragma unroll
    for (int i = 0; i < 8; ++i) {
        const v4u c = v[W - 1 + i];
        pool_acc(s, c, 1.f);
        const int n = (t0 + i + 1 < W) ? (t0 + i + 1) : W;
        const float inv = __builtin_amdgcn_rcpf((float)n);
        v4u o; o.x = cvtpk(s[0] * inv - bflo(c.x), s[1] * inv - bfhi(c.x)); o.y = cvtpk(s[2] * inv - bflo(c.y), s[3] * inv - bfhi(c.y));
        o.z = cvtpk(s[4] * inv - bflo(c.z), s[5] * inv - bfhi(c.z)); o.w = cvtpk(s[6] * inv - bflo(c.w), s[7] * inv - bfhi(c.w));
        *(v4u*)(MIXIN + (size_t)(m0 + i) * D + col) = o;
        pool_acc(s, v[i], (t0 + i - (W - 1) >= 0) ? -1.f : 0.f);
    }
}
__device__ __forceinline__ void p2_pool(const bf16* PROJ, bf16* MIXIN, int gtid, int nthreads) {
    for (int item = gtid; item < (M / 8) * 64; item += nthreads) {
        const int cgl = item & 15, rsub = (item >> 4) & 3, g = (item >> 6) & 3, rb = (item >> 8) * 4 + rsub;
        const int col = g * 128 + cgl * 8, m0 = rb * 8;
        if (g == 0) pool_item<2>(PROJ, MIXIN, m0, col); else if (g == 1) pool_item<4>(PROJ, MIXIN, m0, col); else if (g == 2) pool_item<8>(PROJ, MIXIN, m0, col); else pool_item<16>(PROJ, MIXIN, m0, col);
    }
}

#define MFMA32(a, b, c) __builtin_amdgcn_mfma_f32_32x32x16_bf16((a), (b), (c), 0, 0, 0)
__device__ __forceinline__ void sb_load_tile(bf16x8 (&kf)[4], s16x4 (&vf)[2][2][2], const bf16* kp, const bf16* vp) {
#pragma unroll
    for (int ks = 0; ks < 4; ++ks) kf[ks] = *(const bf16x8*)(kp + 16 * ks);
#pragma unroll
    for (int db = 0; db < 2; ++db)
#pragma unroll
        for (int s = 0; s < 2; ++s)
#pragma unroll
            for (int hf = 0; hf < 2; ++hf) vf[db][s][hf] = *(const s16x4*)(vp + ((4 * s + 2 * hf) * 64 + 32 * db) * 4);
}
__device__ __forceinline__ void sb_unit(const bf16* PROJ, const bf16* VT, const float* g_sb, bf16* MIXIN, int b, int h, int qb, int lane) {
    const int r = lane & 31, hi = lane >> 5, t0 = qb * 32;
    const size_t mrow0 = (size_t)b * SEQ + t0;
    bf16x8 qf[4];
    { const bf16* qp = PROJ + (mrow0 + r) * LDP + 512 + h * HD + 8 * hi;
#pragma unroll
      for (int ks = 0; ks < 4; ++ks) qf[ks] = *(const bf16x8*)(qp + 16 * ks); }
    f32x16 o0, o1;
#pragma unroll
    for (int i = 0; i < 16; ++i) { o0[i] = 0.f; o1[i] = 0.f; }
    float carry = 1.f;
    const bf16* kbase = PROJ + ((size_t)b * SEQ + r) * LDP + 1024 + h * HD + 8 * hi;
    const bf16* vbase = VT + ((size_t)(b * NH + h) * (SEQ / 4) + hi) * 256 + r * 4;
    bf16x8 kf[4], kn[4]; s16x4 vf[2][2][2], vn[2][2][2];
    sb_load_tile(kf, vf, kbase + (size_t)t0 * LDP, vbase + (size_t)t0 * 64);
    for (int kt = t0; kt >= 0; kt -= 32) {
        const bool more = kt >= 32;
        if (more) sb_load_tile(kn, vn, kbase + (size_t)(kt - 32) * LDP, vbase + (size_t)(kt - 32) * 64);
        f32x16 s;
#pragma unroll
        for (int i = 0; i < 16; ++i) s[i] = 0.f;
#pragma unroll
        for (int ks = 0; ks < 4; ++ks) s = MFMA32(kf[ks], qf[ks], s);
        const bool diag = (kt == t0);
        float f[16], gp[4], pp[4], a[16];
#pragma unroll
        for (int i = 0; i < 16; ++i) {
            const int kr = (i & 3) + 8 * (i >> 2) + 4 * hi;
            const float e = __builtin_amdgcn_exp2f(s[i] * (0.125f * 1.4426950408889634f));
            const float fi = __builtin_amdgcn_rcpf(1.f + e);
            f[i] = (!diag || (kr < r)) ? fi : 1.f;
        }
#pragma unroll
        for (int g4 = 0; g4 < 4; ++g4) gp[g4] = (f[4 * g4] * f[4 * g4 + 1]) * (f[4 * g4 + 2] * f[4 * g4 + 3]);
#pragma unroll
        for (int g4 = 0; g4 < 4; ++g4) pp[g4] = __shfl_xor(gp[g4], 32);
        float base = carry;
#pragma unroll
        for (int g4 = 3; g4 >= 0; --g4) {
            float run = (hi == 0) ? base * pp[g4] : base;
#pragma unroll
            for (int e = 3; e >= 0; --e) { const int i = 4 * g4 + e; const float nxt = run * f[i]; a[i] = run - nxt; run = nxt; }
            base *= gp[g4] * pp[g4];
        }
        carry = base;
        bf16x8 a0, a1;
        { v4u w0, w1; w0.x = cvtpk(a[0], a[1]); w0.y = cvtpk(a[2], a[3]); w0.z = cvtpk(a[4], a[5]); w0.w = cvtpk(a[6], a[7]);
          w1.x = cvtpk(a[8], a[9]); w1.y = cvtpk(a[10], a[11]); w1.z = cvtpk(a[12], a[13]); w1.w = cvtpk(a[14], a[15]);
          a0 = __builtin_bit_cast(bf16x8, w0); a1 = __builtin_bit_cast(bf16x8, w1); }
        {
            const bf16x8 v00 = __builtin_shufflevector(vf[0][0][0], vf[0][0][1], 0, 1, 2, 3, 4, 5, 6, 7), v01 = __builtin_shufflevector(vf[0][1][0], vf[0][1][1], 0, 1, 2, 3, 4, 5, 6, 7);
            const bf16x8 v10 = __builtin_shufflevector(vf[1][0][0], vf[1][0][1], 0, 1, 2, 3, 4, 5, 6, 7), v11 = __builtin_shufflevector(vf[1][1][0], vf[1][1][1], 0, 1, 2, 3, 4, 5, 6, 7);
            o0 = MFMA32(v00, a0, o0); o0 = MFMA32(v01, a1, o0);
            o1 = MFMA32(v10, a0, o1); o1 = MFMA32(v11, a1, o1);
        }
        if (__all(carry < 1e-37f)) break;
        if (more) {
#pragma unroll
            for (int ks = 0; ks < 4; ++ks) kf[ks] = kn[ks];
#pragma unroll
            for (int db = 0; db < 2; ++db)
#pragma unroll
                for (int s2 = 0; s2 < 2; ++s2)
#pragma unroll
                    for (int hf = 0; hf < 2; ++hf) vf[db][s2][hf] = vn[db][s2][hf];
        }
    }
    float ss = 0.f;
#pragma unroll
    for (int i = 0; i < 16; ++i) ss += o0[i] * o0[i] + o1[i] * o1[i];
    ss += __shfl_xor(ss, 32);
    const float rstd = 1.f / sqrtf(ss * (1.f / HD) + EPS);
    bf16* op = MIXIN + (mrow0 + r) * D + 512 + h * HD + 4 * hi;
    const float* gp = g_sb + h * HD + 4 * hi;
#pragma unroll
    for (int g4 = 0; g4 < 4; ++g4) {
        const f32x4 ga = *(const f32x4*)(gp + 8 * g4), gb = *(const f32x4*)(gp + 32 + 8 * g4);
        v2u wa, wb;
        wa.x = cvtpk(o0[4 * g4] * rstd * ga.x, o0[4 * g4 + 1] * rstd * ga.y); wa.y = cvtpk(o0[4 * g4 + 2] * rstd * ga.z, o0[4 * g4 + 3] * rstd * ga.w);
        wb.x = cvtpk(o1[4 * g4] * rstd * gb.x, o1[4 * g4 + 1] * rstd * gb.y); wb.y = cvtpk(o1[4 * g4 + 2] * rstd * gb.z, o1[4 * g4 + 3] * rstd * gb.w);
        *(v2u*)(op + 8 * g4) = wa; *(v2u*)(op + 32 + 8 * g4) = wb;
    }
}

__device__ __forceinline__ void p4_rows(const float* x, const bf16* MIX, const float* SS, const float* g_post, const float* g_pre2, float* out, bf16* XN, int mfirst, int mend, int mstep, int lane) {
    f32x4 gp[4], gq[4];
#pragma unroll
    for (int j = 0; j < 4; ++j) { gp[j] = *(const f32x4*)(g_post + 4 * lane + 256 * j); gq[j] = *(const f32x4*)(g_pre2 + 4 * lane + 256 * j); }
    for (int m = mfirst; m < mend; m += mstep) {
        const f32x4* sp = (const f32x4*)(SS + (size_t)m * 16); const f32x4 s0 = sp[0], s1 = sp[1], s2 = sp[2], s3 = sp[3];
        const float tot = ((s0.x + s0.y) + (s0.z + s0.w)) + ((s1.x + s1.y) + (s1.z + s1.w)) + ((s2.x + s2.y) + (s2.z + s2.w)) + ((s3.x + s3.y) + (s3.z + s3.w));
        const float r1 = 1.f / sqrtf(tot * (1.f / D) + EPS);
        const f32x4* xr = (const f32x4*)(x + (size_t)m * D) + lane; const v2u* mr = (const v2u*)(MIX + (size_t)m * D) + lane;
        f32x4 hv[4]; float q = 0.f;
#pragma unroll
        for (int j = 0; j < 4; ++j) { const f32x4 xv = xr[64 * j]; const v2u mw = mr[64 * j]; const f32x4 mv = {bflo(mw.x), bfhi(mw.x), bflo(mw.y), bfhi(mw.y)};
            hv[j] = xv + mv * r1 * gp[j]; q += (hv[j].x * hv[j].x + hv[j].y * hv[j].y) + (hv[j].z * hv[j].z + hv[j].w * hv[j].w); }
        const float r2 = 1.f / sqrtf(wave_sum(q) * (1.f / D) + EPS);
        f32x4* orow = (f32x4*)(out + (size_t)m * D) + lane; v2u* nrow = (v2u*)(XN + (size_t)m * D) + lane;
#pragma unroll
        for (int j = 0; j < 4; ++j) { orow[64 * j] = hv[j]; const f32x4 y = hv[j] * r2 * gq[j]; v2u w; w.x = cvtpk(y.x, y.y); w.y = cvtpk(y.z, y.w); nrow[64 * j] = w; }
    }
}
__device__ __forceinline__ void p7_rows(const bf16* MIX, const float* SS, const float* SSE, const float* g_post, const float* h1, bf16* XN, float* RSTDE, float* RSTD2, int mfirst, int mend, int mstep, int lane) {
    f32x4 gp[4];
#pragma unroll
    for (int j = 0; j < 4; ++j) gp[j] = *(const f32x4*)(g_post + 4 * lane + 256 * j);
    for (int m = mfirst; m < mend; m += mstep) {
        const f32x4* sp = (const f32x4*)(SS + (size_t)m * 16); const f32x4 s0 = sp[0], s1 = sp[1], s2 = sp[2], s3 = sp[3];
        const float tot = ((s0.x + s0.y) + (s0.z + s0.w)) + ((s1.x + s1.y) + (s1.z + s1.w)) + ((s2.x + s2.y) + (s2.z + s2.w)) + ((s3.x + s3.y) + (s3.z + s3.w));
        const float r1 = 1.f / sqrtf(tot * (1.f / D) + EPS);
        const f32x4* ep = (const f32x4*)(SSE + (size_t)m * 16); const f32x4 e0 = ep[0], e1 = ep[1], e2 = ep[2], e3 = ep[3];
        const float te = ((e0.x + e0.y) + (e0.z + e0.w)) + ((e1.x + e1.y) + (e1.z + e1.w)) + ((e2.x + e2.y) + (e2.z + e2.w)) + ((e3.x + e3.y) + (e3.z + e3.w));
        if (lane == 0) { RSTDE[m] = 1.f / sqrtf(te * (1.f / D) + EPS); RSTD2[m] = r1; }
        const f32x4* irow = (const f32x4*)(h1 + (size_t)m * D) + lane; const v2u* mr = (const v2u*)(MIX + (size_t)m * D) + lane; v2u* nrow = (v2u*)(XN + (size_t)m * D) + lane;
#pragma unroll
        for (int j = 0; j < 4; ++j) { const f32x4 hv0 = irow[64 * j]; const v2u mw = mr[64 * j]; const f32x4 mv = {bflo(mw.x), bfhi(mw.x), bflo(mw.y), bfhi(mw.y)};
            const f32x4 hv = hv0 + mv * r1 * gp[j]; v2u w; w.x = cvtpk(hv.x, hv.y); w.y = cvtpk(hv.z, hv.w); nrow[64 * j] = w; }
    }
}

__global__ void __launch_bounds__(NWAVES * 64, 2) fwd_megakernel(Args args) {
    extern __shared__ __attribute__((aligned(16))) unsigned char lds_raw[];
    LAS unsigned char* lds = (LAS unsigned char*)lds_raw;
    const int tid = threadIdx.x, lane = tid & 63, wave = __builtin_amdgcn_readfirstlane(tid >> 6);
    volatile LAS unsigned* MISC = (volatile LAS unsigned*)(lds + MISC_OFF);
    if (tid < 32) MISC[tid] = 0u;
    __syncthreads();
    { kargp_t kp = karg_fresh(); (void)xcd_barrier_post((unsigned*)(KWS(kp) + WS_CTL), MISC + 8);
      if (karg<int>(kp, 148) > 1000) cg::this_grid().sync(); }
#define MKBAR() XcdBarrier bar; bar.bar = (unsigned*)(KWS(karg_fresh()) + WS_CTL); bar.x = xb_xcc_id(); bar.st = MISC + 8
#define SEAM() do { MKBAR(); xcd_barrier(bar); } while (0)
#define SEAML() do { MKBAR(); if (__builtin_amdgcn_readfirstlane((int)MISC[11]) != 0) xcd_barrier_local(bar); else xcd_barrier(bar); } while (0)
#define CDEAL() ((__builtin_amdgcn_readfirstlane((int)MISC[11]) != 0) ? __builtin_amdgcn_readfirstlane((int)MISC[12]) : (int)blockIdx.x)

    { kargp_t kp = karg_fresh(); p0_prologue(kp, lds, tid, lane, wave, (int)gridDim.x); }
    SEAM();
    {
        if (tid == 0) { unsigned* bw = (unsigned*)(KWS(karg_fresh()) + WS_CTL); unsigned ok = (gridDim.x == 256) ? 1u : 0u;
            for (unsigned j = 0; j < 16; ++j) { const unsigned c = xb_ld(&bw[XB_XCNT(j)]); ok &= (j < 8) ? (c == 32u ? 1u : 0u) : (c == 0u ? 1u : 0u); }
            MISC[12] = MISC[10] * 8u + xb_xcc_id(); MISC[11] = ok; }
        __syncthreads();
    }
    {
        kargp_t kp = karg_fresh(); unsigned char* ws = KWS(kp); const int G = (int)gridDim.x;
        bf16 *WinT = (bf16*)(ws + WS_WIN), *WpleT = (bf16*)(ws + WS_WPLE), *XN = (bf16*)(ws + WS_XN), *PB = (bf16*)(ws + WS_PB), *PROJ = (bf16*)(ws + WS_PROJ), *VT = (bf16*)(ws + WS_VT), *ERAW = (bf16*)(ws + WS_ERAW);
        float* SSE = (float*)(ws + WS_SSE);
        const bool eraw_first = ((blockIdx.x >> 3) & 1) != 0;
        if (eraw_first) {
            pg8::Gemm g{PB, WpleT, M, D, PLE}; pg8::StaticOrder S; S.init(M, D, G, (int)blockIdx.x);
            pg8::EpiStore<0, true> E{ERAW, D, SSE};
            pg8::gemm_phase<pg8::EpiStore<0, true>, pg8::StaticOrder, PG8_ALIGN, PG8_SP2>(lds, g, S, E);
        }
        {
            pg8::Gemm g{XN, WinT, M, LDP, D}; pg8::StaticOrder S; S.init(M, LDP, G, (int)blockIdx.x);
            pg8::EpiStore<0, false> E{PROJ, LDP, nullptr};
            pg8::gemm_phase<pg8::EpiStore<0, false>, pg8::StaticOrder, PG8_ALIGN, PG8_SP2>(lds, g, S, E);
        }
        {
            pg8::Gemm g{WinT + (size_t)1536 * D, XN, 512, M, D}; pg8::StaticOrder S; S.init(512, M, G, (int)((blockIdx.x + G / 2) % G));
            pg8::EpiVT4 E{VT};
            pg8::gemm_phase<pg8::EpiVT4, pg8::StaticOrder, PG8_ALIGN, PG8_SP2>(lds, g, S, E);
        }
        if (!eraw_first) {
            pg8::Gemm g{PB, WpleT, M, D, PLE}; pg8::StaticOrder S; S.init(M, D, G, (int)blockIdx.x);
            pg8::EpiStore<0, true> E{ERAW, D, SSE};
            pg8::gemm_phase<pg8::EpiStore<0, true>, pg8::StaticOrder, PG8_ALIGN, PG8_SP2>(lds, g, S, E);
        }
    }
    SEAM();
    {
        kargp_t kp = karg_fresh(); unsigned char* ws = KWS(kp); const int G = (int)gridDim.x;
        const bf16 *PROJ = (const bf16*)(ws + WS_PROJ), *VT = (const bf16*)(ws + WS_VT); bf16* MIXIN = (bf16*)(ws + WS_MIXIN);
        p2_pool(PROJ, MIXIN, blockIdx.x * 512 + tid, G * 512);
        const float* g_sb = KIN(kp, 6);
        constexpr int NU = BATCH * NH * (SEQ / 32); const int upw = (NU + G - 1) / G, ubeg = blockIdx.x * upw, uend = (ubeg + upw < NU) ? ubeg + upw : NU;
        if (wave >= 4) late_weights(kp, lds, lane, wave, G);
        for (int u = ubeg + wave; u < uend; u += NWAVES) { const int qb = u & 255, bh = u >> 8, h = bh & 7, b = bh >> 3; sb_unit(PROJ, VT, g_sb, MIXIN, b, h, qb, lane); }
        if (wave < 4) late_weights(kp, lds, lane, wave, G);
    }
    SEAM();
    {
        kargp_t kp = karg_fresh(); unsigned char* ws = KWS(kp);
        pg8::Gemm g{(const bf16*)(ws + WS_MIXIN), (const bf16*)(ws + WS_WOUT), M, D, D}; pg8::StaticOrder S; S.init(M, D, (int)gridDim.x, CDEAL());
        pg8::EpiStore<0, true> E{(bf16*)(ws + WS_MIX), D, (float*)(ws + WS_SS1)};
        pg8::gemm_phase<pg8::EpiStore<0, true>, pg8::StaticOrder, PG8_ALIGN, PG8_SP2>(lds, g, S, E);
    }
    SEAML();
    {
        kargp_t kp = karg_fresh(); unsigned char* ws = KWS(kp);
        const bool fast = __builtin_amdgcn_readfirstlane((int)MISC[11]) != 0; const int cd = CDEAL(), xcc = cd & 7;
        const int rfirst = fast ? 2048 * xcc + (cd >> 3) * NWAVES + wave : (int)blockIdx.x * NWAVES + wave, rend = fast ? 2048 * (xcc + 1) : M, rstep = fast ? 256 : (int)gridDim.x * NWAVES;
        p4_rows(KIN(kp, 0), (const bf16*)(ws + WS_MIX), (const float*)(ws + WS_SS1), KIN(kp, 8), KIN(kp, 9), KOUT(kp), (bf16*)(ws + WS_XN), rfirst, rend, rstep, lane);
    }
    SEAML();
    {
        kargp_t kp = karg_fresh(); unsigned char* ws = KWS(kp);
        pg8::Gemm g{(const bf16*)(ws + WS_XN), (const bf16*)(ws + WS_WUP), M, FF, D}; pg8::StaticOrder S; S.init(M, FF, (int)gridDim.x, CDEAL());
        pg8::EpiStore<1, false> E{(bf16*)(ws + WS_A), FF, nullptr};
        pg8::gemm_phase<pg8::EpiStore<1, false>, pg8::StaticOrder, PG8_ALIGN, PG8_SP2>(lds, g, S, E);
    }
    SEAML();
    {
        kargp_t kp = karg_fresh(); unsigned char* ws = KWS(kp);
        pg8::Gemm g{(const bf16*)(ws + WS_A), (const bf16*)(ws + WS_WDOWN), M, D, FF}; pg8::StaticOrder S; S.init(M, D, (int)gridDim.x, CDEAL());
        pg8::EpiStore<0, true> E{(bf16*)(ws + WS_MIX), D, (float*)(ws + WS_SS2)};
        pg8::gemm_phase<pg8::EpiStore<0, true>, pg8::StaticOrder, PG8_ALIGN, PG8_SP2>(lds, g, S, E);
    }
    SEAML();
    {
        kargp_t kp = karg_fresh(); unsigned char* ws = KWS(kp);
        const bool fast = __builtin_amdgcn_readfirstlane((int)MISC[11]) != 0; const int cd = CDEAL(), xcc = cd & 7;
        const int rfirst = fast ? 2048 * xcc + (cd >> 3) * NWAVES + wave : (int)blockIdx.x * NWAVES + wave, rend = fast ? 2048 * (xcc + 1) : M, rstep = fast ? 256 : (int)gridDim.x * NWAVES;
        p7_rows((const bf16*)(ws + WS_MIX), (const float*)(ws + WS_SS2), (const float*)(ws + WS_SSE), KIN(kp, 12), KOUT(kp), (bf16*)(ws + WS_XN), (float*)(ws + WS_RSTDE), (float*)(ws + WS_RSTDE) + M, rfirst, rend, rstep, lane);
    }
    SEAML();
    {
        kargp_t kp = karg_fresh(); unsigned char* ws = KWS(kp);
        pg8::Gemm g{(const bf16*)(ws + WS_XN), (const bf16*)(ws + WS_WGATE), M, D, D}; pg8::StaticOrder S; S.init(M, D, (int)gridDim.x, CDEAL());
        pg8::EpiFinal E{KOUT(kp), (const bf16*)(ws + WS_MIX), (const float*)(ws + WS_RSTDE) + M, KIN(kp, 12), (const bf16*)(ws + WS_ERAW), (const float*)(ws + WS_RSTDE), KIN(kp, 15)};
        pg8::gemm_phase<pg8::EpiFinal, pg8::StaticOrder, PG8_ALIGN, PG8_SP2>(lds, g, S, E);
    }
#undef MKBAR
#undef SEAM
#undef SEAML
#undef CDEAL
}

extern "C" void kernel_launch(void* const* d_in, const int* in_sizes, int n_in, void* d_out, int out_size, void* d_ws, size_t ws_size, hipStream_t stream) {
    static int grid = 0;
    if (grid == 0) {
        if (n_in != 16 || in_sizes[0] != M * D || out_size != M * D || ws_size < WS_END) { fprintf(stderr, "kernel_launch: unexpected shapes (n_in %d, in0 %d, out %d, ws %zu)\n", n_in, n_in > 0 ? in_sizes[0] : -1, out_size, ws_size); grid = -1; return; }
        int dev = 0, cus = 0, per_cu = 0;
        if (hipGetDevice(&dev) != hipSuccess || hipDeviceGetAttribute(&cus, hipDeviceAttributeMultiprocessorCount, dev) != hipSuccess) { grid = -1; return; }
        if (hipFuncSetAttribute((const void*)fwd_megakernel, hipFuncAttributeMaxDynamicSharedMemorySize, LDS_BYTES) != hipSuccess) { fprintf(stderr, "kernel_launch: hipFuncSetAttribute failed\n"); grid = -1; return; }
        if (hipOccupancyMaxActiveBlocksPerMultiprocessor(&per_cu, (const void*)fwd_megakernel, NWAVES * 64, LDS_BYTES) != hipSuccess || per_cu < 1) { fprintf(stderr, "kernel_launch: occupancy query says %d\n", per_cu); per_cu = 1; }
        (void)hipGetLastError();
        grid = cus * per_cu;
    }
    if (grid < 0) return;
    if (hipMemsetAsync((char*)d_ws + WS_CTL, 0, CTL_ZERO_BYTES, stream) != hipSuccess) { fprintf(stderr, "kernel_launch: memset failed\n"); return; }
    Args a{};
    for (int i = 0; i < 16; ++i) a.in[i] = (const float*)d_in[i];
    a.out = (float*)d_out; a.ws = (unsigned char*)d_ws;
    a.ph_lo = 0; a.ph_hi = N_PHASES;
    void* kargs[] = {&a};
    hipError_t e = hipLaunchCooperativeKernel((const void*)fwd_megakernel, dim3(grid), dim3(NWAVES * 64), kargs, LDS_BYTES, stream);
    if (e != hipSuccess) fprintf(stderr, "cooperative launch failed: %s (grid %d)\n", hipGetErrorString(e), grid);
}
```

```cpp
#include <hip/hip_runtime.h>
#include <hip/hip_cooperative_groups.h>
#include <cstdio>
#include <cstdint>
namespace cg = cooperative_groups;
namespace pg8 {
#define PG8_LAS __attribute__((address_space(3)))
typedef unsigned short bf16_t;
typedef short bf16x8 __attribute__((ext_vector_type(8)));
typedef float f32x4 __attribute__((ext_vector_type(4)));
typedef unsigned u32x4 __attribute__((ext_vector_type(4)));
constexpr int BM = 256, BK = 64, HALF = 128, HTB = HALF * BK * 2  , STAGE_BYTES = 8 * HTB, NXCD = 8, WGM = 8;

__host__ __device__ __forceinline__ int lds_byte(int r, int c) { const int st = (r >> 4) * 2 + (c >> 5), rr = r & 15, cc = c & 31, ob = rr * 64 + cc * 2; return st * 1024 + (ob ^ (((ob >> 9) & 1) << 5)); }
__host__ __device__ __forceinline__ void stage_rc(int b, int& R, int& C) { const int st = b / 1024, sb = b % 1024, swz = sb ^ (((sb >> 9) & 1) << 5); R = (st >> 1) * 16 + swz / 64; C = (st & 1) * 32 + (swz % 64) / 2; }
__host__ __device__ __forceinline__ int perm32(int rho) { const int n = rho >> 4, i = rho & 15; return 8 * (i >> 2) + 4 * n + (i & 3); }

struct Unit { int pm, pn; };
struct Gemm { const bf16_t* A; const bf16_t* Bt; int M, N, K; };

struct StaticOrder {
    int nM, nN, nwg, G, c;
    __host__ __device__ void init(int M, int N, int G_, int c_) { nM = M / BM; nN = N / BM; nwg = nM * nN; G = G_; c = c_; }
    __host__ __device__ bool next(int i, Unit& u) const {
        const long L = (long)i * G + c; if (L >= nwg) return false;
        int wgid = (int)L; { const int q = nwg / NXCD, r = nwg % NXCD, xcd = wgid % NXCD, off = wgid / NXCD; wgid = (xcd < r ? xcd * (q + 1) : r * (q + 1) + (xcd - r) * q) + off; }
        const int nig = WGM * nN, gid = wgid / nig, fm = gid * WGM, gsz = (nM - fm) < WGM ? (nM - fm) : WGM;
        u.pm = fm + ((wgid % nig) % gsz); u.pn = (wgid % nig) / gsz; return true;
    }
    __device__ __forceinline__ void a_ready(const Unit&) const {}
    __device__ __forceinline__ void done(const Unit&) const {}
};

__device__ __forceinline__ unsigned cvt_pk_bf16(float lo, float hi) { unsigned r; asm volatile("v_cvt_pk_bf16_f32 %0, %1, %2" : "=v"(r) : "v"(lo), "v"(hi)); return r; }
typedef float f32x2 __attribute__((ext_vector_type(2)));
typedef float f32x2_t __attribute__((ext_vector_type(2)));
typedef unsigned u32x2 __attribute__((ext_vector_type(2)));
typedef __bf16 bf16x2_t __attribute__((ext_vector_type(2)));
__device__ __forceinline__ unsigned cvtpk(float lo, float hi) { f32x2_t v = {lo, hi}; bf16x2_t b = __builtin_convertvector(v, bf16x2_t); return __builtin_bit_cast(unsigned, b); }
__device__ __forceinline__ float bflo(unsigned w) { return __builtin_bit_cast(float, w << 16); }
__device__ __forceinline__ float bfhi(unsigned w) { return __builtin_bit_cast(float, w & 0xffff0000u); }

template <int ACT, bool SS> struct EpiStore {
    static constexpr bool PERM = true, AFTER_DRAIN = false;
    bf16_t* O; int ldc; float* ss;
    __device__ __forceinline__ void operator()(const f32x4 (&acc)[2][2][4][2], const Unit& u, int wr, int wc, int fr, int fq) const {
        const int row0 = u.pm * BM + wr * 64 + fr, col0 = u.pn * BM + wc * 32 + 8 * fq;
#pragma unroll
        for (int ai = 0; ai < 2; ++ai)
#pragma unroll
            for (int m = 0; m < 4; ++m) { const int row = row0 + ai * HALF + m * 16; bf16_t* rowp = O + (size_t)row * ldc + col0; float s = 0.f;
#pragma unroll
                for (int bj = 0; bj < 2; ++bj) { f32x4 v0 = acc[ai][bj][m][0], v1 = acc[ai][bj][m][1];
                    if (ACT == 1) {
#pragma unroll
                        for (int e = 0; e < 4; ++e) { const float a = fmaxf(v0[e], 0.f), b = fmaxf(v1[e], 0.f); v0[e] = a * a; v1[e] = b * b; } }
                    if (SS) s += (v0[0] * v0[0] + v0[1] * v0[1]) + (v0[2] * v0[2] + v0[3] * v0[3]) + (v1[0] * v1[0] + v1[1] * v1[1]) + (v1[2] * v1[2] + v1[3] * v1[3]);
                    u32x4 w; w.x = cvtpk(v0[0], v0[1]); w.y = cvtpk(v0[2], v0[3]); w.z = cvtpk(v1[0], v1[1]); w.w = cvtpk(v1[2], v1[3]);
                    *(u32x4*)(rowp + bj * HALF) = w; }
                if (SS) { s += __shfl_xor(s, 16); s += __shfl_xor(s, 32); if (fq == 0) ss[(size_t)row * 16 + u.pn * 4 + wc] = s; } }
    }
};
struct EpiVT4 {
    static constexpr bool PERM = true, AFTER_DRAIN = false;
    bf16_t* O;
    __device__ __forceinline__ void operator()(const f32x4 (&acc)[2][2][4][2], const Unit& u, int wr, int wc, int fr, int fq) const {
        const int row0 = u.pm * BM + wr * 64 + fr, col0 = u.pn * BM + wc * 32 + 8 * fq;
#pragma unroll
        for (int ai = 0; ai < 2; ++ai)
#pragma unroll
            for (int m = 0; m < 4; ++m) { const int row = row0 + ai * HALF + m * 16, h = row >> 6, d = row & 63;
#pragma unroll
                for (int bj = 0; bj < 2; ++bj) { const int tok = col0 + bj * HALF, b = tok >> 13, tok4 = (tok & 8191) >> 2;
                    bf16_t* dst = O + (((size_t)(b * 8 + h) * 2048 + tok4) * 64 + d) * 4;
                    const f32x4 v0 = acc[ai][bj][m][0], v1 = acc[ai][bj][m][1];
                    u32x2 w0, w1; w0.x = cvtpk(v0[0], v0[1]); w0.y = cvtpk(v0[2], v0[3]); w1.x = cvtpk(v1[0], v1[1]); w1.y = cvtpk(v1[2], v1[3]);
                    *(u32x2*)dst = w0; *(u32x2*)(dst + 256) = w1; } }
    }
};
struct EpiFinal {
    static constexpr bool PERM = true, AFTER_DRAIN = false;
    float* out; const bf16_t* h2; const bf16_t* eraw; const float* rstd_e; const float* g;
    __device__ __forceinline__ void operator()(const f32x4 (&acc)[2][2][4][2], const Unit& u, int wr, int wc, int fr, int fq) const {
        const int row0 = u.pm * BM + wr * 64 + fr, col0 = u.pn * BM + wc * 32 + 8 * fq;
        f32x4 gv[2][2];
#pragma unroll
        for (int bj = 0; bj < 2; ++bj) { gv[bj][0] = *(const f32x4*)(g + col0 + bj * HALF); gv[bj][1] = *(const f32x4*)(g + col0 + bj * HALF + 4); }
#pragma unroll
        for (int ai = 0; ai < 2; ++ai)
#pragma unroll
            for (int m = 0; m < 4; ++m) { const int row = row0 + ai * HALF + m * 16; const float re = rstd_e[row];
#pragma unroll
                for (int bj = 0; bj < 2; ++bj) { float* op = out + (size_t)row * 1024 + col0 + bj * HALF;
                    const u32x4 ew = *(const u32x4*)(eraw + (size_t)row * 1024 + col0 + bj * HALF), hw = *(const u32x4*)(h2 + (size_t)row * 1024 + col0 + bj * HALF);
                    const f32x4 e0 = {bflo(ew.x), bfhi(ew.x), bflo(ew.y), bfhi(ew.y)}, e1 = {bflo(ew.z), bfhi(ew.z), bflo(ew.w), bfhi(ew.w)};
                    const f32x4 h0 = {bflo(hw.x), bfhi(hw.x), bflo(hw.y), bfhi(hw.y)}, h1 = {bflo(hw.z), bfhi(hw.z), bflo(hw.w), bfhi(hw.w)};
                    f32x4 o0, o1;
#pragma unroll
                    for (int e = 0; e < 4; ++e) {
                        const float g0 = __builtin_amdgcn_rcpf(1.f + __builtin_amdgcn_exp2f(acc[ai][bj][m][0][e] * -1.4426950408889634f));
                        const float g1 = __builtin_amdgcn_rcpf(1.f + __builtin_amdgcn_exp2f(acc[ai][bj][m][1][e] * -1.4426950408889634f));
                        o0[e] = h0[e] + g0 * (e0[e] * re * gv[bj][0][e]); o1[e] = h1[e] + g1 * (e1[e] * re * gv[bj][1][e]); }
                    *(f32x4*)op = o0; *(f32x4*)(op + 4) = o1; }
                asm volatile("" ::: "memory"); }
    }
};
template <class Epi, class Sched, bool ALIGN_EPI = false, bool SP2 = false>
__device__ __forceinline__ void gemm_phase(PG8_LAS unsigned char* lds, const Gemm g, const Sched& S, const Epi& E) {
    const int tid = threadIdx.x, wid = __builtin_amdgcn_readfirstlane(tid >> 6), lane = tid & 63, wr = wid >> 2, wc = wid & 3, fr = lane & 15, fq = lane >> 4;
    const int K = g.K, nt = K / BK;
    unsigned voffA[2], voffB[2];
#pragma unroll
    for (int i = 0; i < 2; ++i) { int R, C; stage_rc(tid * 16 + i * 8192, R, C); const int Rb = Epi::PERM ? ((R & ~31) + perm32(R & 31)) : R;
        voffA[i] = (unsigned)(R * K + C) * 2u; voffB[i] = (unsigned)(Rb * K + C) * 2u; }
    const size_t kstep = (size_t)(BK * 2);
    const size_t hstep = (size_t)HALF * K * 2;
    const size_t tstep = 2 * hstep;
    const unsigned ldsw = (unsigned)wid * 1024u;
    const int aoff = lds_byte(wr * 64 + fr, fq * 8), boff = lds_byte(wc * 32 + fr, fq * 8);
#define PG8_SA(b, h) (((b) * 2 + (h)) * HTB)
#define PG8_SB(b, h) ((4 + (b) * 2 + (h)) * HTB)
#define PG8_STAGE(bufoff, gbase, voff) do { _Pragma("unroll") for (int _i = 0; _i < 2; ++_i) \
        __builtin_amdgcn_global_load_lds((const unsigned*)((const char*)(gbase) + (voff)[_i]), (PG8_LAS unsigned*)(lds + (bufoff) + ldsw + _i * 8192), 16, 0, 0); } while (0)
#define PG8_LDA(dst, b, h) do { _Pragma("unroll") for (int m = 0; m < 4; ++m) _Pragma("unroll") for (int k = 0; k < 2; ++k) dst[m][k] = *(const PG8_LAS bf16x8*)(lds + PG8_SA(b, h) + aoff + m * 2048 + k * 1024); } while (0)
#define PG8_LDB(dst, b, h) do { _Pragma("unroll") for (int n = 0; n < 2; ++n) _Pragma("unroll") for (int k = 0; k < 2; ++k) dst[n][k] = *(const PG8_LAS bf16x8*)(lds + PG8_SB(b, h) + boff + n * 2048 + k * 1024); } while (0)
#define PG8_MMA(ai, bj, At, Bt) do { __builtin_amdgcn_s_setprio(1); _Pragma("unroll") for (int m = 0; m < 4; ++m) _Pragma("unroll") for (int n = 0; n < 2; ++n) _Pragma("unroll") for (int k = 0; k < 2; ++k) \
        acc[ai][bj][m][n] = __builtin_amdgcn_mfma_f32_16x16x32_bf16(Bt[n][k], At[m][k], acc[ai][bj][m][n], 0, 0, 0); __builtin_amdgcn_s_setprio(0); } while (0)
#define PG8_WAIT_V(n) asm volatile("s_waitcnt vmcnt(" #n ")" ::: "memory")
#define PG8_WAIT_L(n) asm volatile("s_waitcnt lgkmcnt(" #n ")" ::: "memory")
#define PG8_BAR __builtin_amdgcn_s_barrier()
#define PG8_SCHED __builtin_amdgcn_sched_barrier(0)
    Unit cur, nxt; int ui = 0;
    if (!S.next(0, cur)) return;
    f32x4 acc[2][2][4][2];
#pragma unroll
    for (int a = 0; a < 2; ++a)
#pragma unroll
        for (int b = 0; b < 2; ++b)
#pragma unroll
            for (int m = 0; m < 4; ++m)
#pragma unroll
                for (int n = 0; n < 2; ++n) acc[a][b][m][n] = (f32x4){0.f, 0.f, 0.f, 0.f};
    bf16x8 At[4][2], B0[2][2], B1[2][2];
    const char* cA = (const char*)g.A + (size_t)cur.pm * tstep; const char* cB = (const char*)g.Bt + (size_t)cur.pn * tstep;
    S.a_ready(cur);
    if constexpr (SP2) {
        PG8_STAGE(PG8_SB(0, 0), cB, voffB); PG8_STAGE(PG8_SB(0, 1), cB + hstep, voffB); PG8_STAGE(PG8_SA(0, 0), cA, voffA); PG8_STAGE(PG8_SA(0, 1), cA + hstep, voffA);
        if (wr == 1) PG8_BAR;
        PG8_WAIT_V(2); PG8_BAR;
        PG8_STAGE(PG8_SB(1, 0), cB + kstep, voffB); PG8_STAGE(PG8_SA(1, 0), cA + kstep, voffA); PG8_STAGE(PG8_SB(1, 1), cB + hstep + kstep, voffB);
        PG8_WAIT_V(6); PG8_BAR;
    } else {
        PG8_STAGE(PG8_SB(0, 0), cB, voffB); PG8_STAGE(PG8_SA(0, 0), cA, voffA); PG8_STAGE(PG8_SB(0, 1), cB + hstep, voffB); PG8_STAGE(PG8_SA(0, 1), cA + hstep, voffA);
        if (wr == 1) PG8_BAR;
        PG8_WAIT_V(4); PG8_BAR;
        PG8_STAGE(PG8_SB(1, 0), cB + kstep, voffB); PG8_STAGE(PG8_SA(1, 0), cA + kstep, voffA); PG8_STAGE(PG8_SB(1, 1), cB + hstep + kstep, voffB);
        PG8_WAIT_V(6); PG8_BAR;
    }
    for (;;) {
        const bool has_next = S.next(ui + 1, nxt);
        const char* nA = has_next ? (const char*)g.A + (size_t)nxt.pm * tstep : cA; const char* nB = has_next ? (const char*)g.Bt + (size_t)nxt.pn * tstep : cB;
        for (int t = 0; t < nt; t += 2) {
            const bool last = (t == nt - 2);
            const char* a1 = cA + (size_t)(t + 1) * kstep;
            const char* a2 = last ? nA : cA + (size_t)(t + 2) * kstep; const char* b2 = last ? nB : cB + (size_t)(t + 2) * kstep;
            const char* a3 = a2 + kstep; const char* b3 = b2 + kstep;
            if (last && has_next) S.a_ready(nxt);
            if constexpr (SP2) {
            PG8_LDB(B0, 0, 0); PG8_LDB(B1, 0, 1); PG8_SCHED; PG8_LDA(At, 0, 0); PG8_STAGE(PG8_SA(1, 1), a1 + hstep, voffA);
            PG8_WAIT_V(8); PG8_WAIT_L(0); PG8_BAR; PG8_MMA(0, 0, At, B0); PG8_MMA(0, 1, At, B1); PG8_BAR; PG8_SCHED;
            PG8_LDA(At, 0, 1); PG8_STAGE(PG8_SB(0, 0), b2, voffB); PG8_STAGE(PG8_SB(0, 1), b2 + hstep, voffB); PG8_STAGE(PG8_SA(0, 0), a2, voffA);
            PG8_WAIT_V(8); PG8_WAIT_L(0); PG8_BAR; PG8_MMA(1, 0, At, B0); PG8_MMA(1, 1, At, B1); PG8_BAR; PG8_SCHED;
            PG8_LDB(B0, 1, 0); PG8_LDB(B1, 1, 1); PG8_SCHED; PG8_LDA(At, 1, 0); PG8_STAGE(PG8_SA(0, 1), a2 + hstep, voffA);
            PG8_WAIT_V(8); PG8_WAIT_L(0); PG8_BAR; PG8_MMA(0, 0, At, B0); PG8_MMA(0, 1, At, B1); PG8_BAR; PG8_SCHED;
            PG8_LDA(At, 1, 1); PG8_STAGE(PG8_SB(1, 0), b3, voffB); PG8_STAGE(PG8_SB(1, 1), b3 + hstep, voffB); PG8_STAGE(PG8_SA(1, 0), a3, voffA);
            PG8_WAIT_V(8); PG8_WAIT_L(0); PG8_BAR; PG8_MMA(1, 0, At, B0); PG8_MMA(1, 1, At, B1); PG8_BAR; PG8_SCHED;
            } else {
            PG8_LDB(B0, 0, 0); PG8_SCHED; PG8_LDA(At, 0, 0); PG8_STAGE(PG8_SA(1, 1), a1 + hstep, voffA);
            PG8_WAIT_L(8); PG8_BAR; PG8_WAIT_L(0); PG8_MMA(0, 0, At, B0); PG8_BAR; PG8_SCHED;
            PG8_LDB(B1, 0, 1); PG8_STAGE(PG8_SB(0, 0), b2, voffB);
            PG8_BAR; PG8_WAIT_L(0); PG8_MMA(0, 1, At, B1); PG8_BAR;
            PG8_LDA(At, 0, 1); PG8_STAGE(PG8_SA(0, 0), a2, voffA);
            PG8_BAR; PG8_WAIT_L(0); PG8_MMA(1, 0, At, B0); PG8_BAR; PG8_SCHED;
            PG8_STAGE(PG8_SB(0, 1), b2 + hstep, voffB);
            PG8_WAIT_V(6); PG8_BAR; PG8_MMA(1, 1, At, B1); PG8_BAR;
            PG8_LDB(B0, 1, 0); PG8_SCHED; PG8_LDA(At, 1, 0); PG8_STAGE(PG8_SA(0, 1), a2 + hstep, voffA);
            PG8_WAIT_L(8); PG8_BAR; PG8_WAIT_L(0); PG8_MMA(0, 0, At, B0); PG8_BAR; PG8_SCHED;
            PG8_LDB(B1, 1, 1); PG8_STAGE(PG8_SB(1, 0), b3, voffB);
            PG8_BAR; PG8_WAIT_L(0); PG8_MMA(0, 1, At, B1); PG8_BAR;
            PG8_LDA(At, 1, 1); PG8_STAGE(PG8_SA(1, 0), a3, voffA);
            PG8_BAR; PG8_WAIT_L(0); PG8_MMA(1, 0, At, B0); PG8_BAR; PG8_SCHED;
            PG8_STAGE(PG8_SB(1, 1), b3 + hstep, voffB);
            PG8_WAIT_V(6); PG8_BAR; PG8_MMA(1, 1, At, B1); PG8_BAR;
            }
        }
        if constexpr (ALIGN_EPI) { if (wr == 0) PG8_BAR; }
        if constexpr (!Epi::AFTER_DRAIN) { E(acc, cur, wr, wc, fr, fq); S.done(cur); }
        if (!has_next) break;
#pragma unroll
        for (int a = 0; a < 2; ++a)
#pragma unroll
            for (int b = 0; b < 2; ++b)
#pragma unroll
                for (int m = 0; m < 4; ++m)
#pragma unroll
                    for (int n = 0; n < 2; ++n) acc[a][b][m][n] = (f32x4){0.f, 0.f, 0.f, 0.f};
        cur = nxt; cA = nA; cB = nB; ++ui;
        if constexpr (ALIGN_EPI) { if (wr == 1) PG8_BAR; }
    }
    PG8_WAIT_V(0);
    if constexpr (!ALIGN_EPI) { if (wr == 0) PG8_BAR; }
    PG8_BAR;
    if constexpr (Epi::AFTER_DRAIN) { E.fused(acc, cur, wr, wc, fr, fq, lds, wid, lane); S.done(cur); }
#undef PG8_SA
#undef PG8_SB
#undef PG8_STAGE
#undef PG8_LDA
#undef PG8_LDB
#undef PG8_MMA
#undef PG8_WAIT_V
#undef PG8_WAIT_L
#undef PG8_BAR
#undef PG8_SCHED
}
}
#ifndef PG8_SP2
#define PG8_SP2 true
#endif
#ifndef PG8_ALIGN
#define PG8_ALIGN true
#endif
#ifndef REPV
#define REPV {1,1,1,1,1,1,1,1,1}
#endif
constexpr int REP[9] = REPV;
#ifndef REP1V
#define REP1V {1,1,1}
#endif
constexpr int REP1[3] = REP1V;
#ifndef MK_MULTI
#define MK_MULTI 0
#endif
constexpr int NWAVES = 8;
constexpr int BATCH = 2, SEQ = 8192, D = 1024, FF = 4096, PLE = 256, NH = 8, HD = 64;
constexpr int M = BATCH * SEQ;
constexpr int LDP = 1536;
constexpr float EPS = 1e-6f;
constexpr int N_PHASES = 9;
constexpr size_t MiB = 1u << 20;
constexpr size_t WS_CTL = 0, CTL_ZERO_BYTES = 65536;
constexpr size_t WS_WIN = 1 * MiB, WS_WPLE = 5 * MiB, WS_WOUT = 6 * MiB, WS_WUP = 8 * MiB, WS_WDOWN = 16 * MiB, WS_WGATE = 24 * MiB;
constexpr size_t WS_SS1 = 26 * MiB, WS_SS2 = 27 * MiB, WS_SSE = 28 * MiB, WS_RSTDE = 29 * MiB;
constexpr size_t WS_A = 32 * MiB;
constexpr size_t WS_PROJ = 32 * MiB, WS_VT = 80 * MiB, WS_PB = 128 * MiB;
constexpr size_t WS_XN = 160 * MiB, WS_ERAW = 192 * MiB, WS_MIX = 224 * MiB, WS_END = 256 * MiB;
constexpr size_t WS_MIXIN = WS_XN;
constexpr int RING_BYTES = 131072, MISC_OFF = RING_BYTES + 320, LDS_BYTES = 147456;

#define GAS __attribute__((address_space(1)))
#define LAS __attribute__((address_space(3)))
typedef unsigned short bf16;
typedef unsigned v4u __attribute__((ext_vector_type(4)));
typedef unsigned v2u __attribute__((ext_vector_type(2)));
typedef float f32x4 __attribute__((ext_vector_type(4)));
typedef float f32x16 __attribute__((ext_vector_type(16)));
typedef short bf16x8 __attribute__((ext_vector_type(8)));
typedef short s16x4 __attribute__((ext_vector_type(4)));
using pg8::cvtpk; using pg8::bflo; using pg8::bfhi;
#define LDS_WAIT() asm volatile("s_waitcnt lgkmcnt(0)" ::: "memory")
#define XB_TMO      128
#define XB_XCNT(j)  (256  + 64 * (j))
#define XB_XSUB(j)  (1280 + 64 * (j))
#define XB_XGEN(j)  (2304 + 64 * (j))
#define XB_TOP      3328
#define XB_TOPGEN   3392
#define XCD_BAR_WORDS 3456
#define XB_SPIN_CAP (1u << 18)

__device__ __forceinline__ unsigned xb_ld(unsigned* p)              { return __hip_atomic_load(p, __ATOMIC_RELAXED, __HIP_MEMORY_SCOPE_AGENT); }
__device__ __forceinline__ unsigned xb_add(unsigned* p, unsigned v) { return __hip_atomic_fetch_add(p, v, __ATOMIC_RELAXED, __HIP_MEMORY_SCOPE_AGENT); }
__device__ __forceinline__ unsigned xb_xcc_id() { return (unsigned)__builtin_amdgcn_s_getreg((3 << 11) | 20) & 0xFu; }
#define XB_SPIN(cond, bar) do { unsigned _sp = 0; while (cond) { __builtin_amdgcn_s_sleep(1); \
    if ((++_sp & 255u) == 0u) { if (xb_ld(&(bar)[XB_TMO])) break; if (_sp > XB_SPIN_CAP) { atomicAdd(&(bar)[XB_TMO], 1u); break; } } } } while (0)

struct XcdBarrier {
    unsigned* bar; unsigned x;
    volatile LAS unsigned* st;
};

__device__ __forceinline__ XcdBarrier xcd_barrier_post(unsigned* bar, volatile LAS unsigned* st) {
    XcdBarrier b; b.bar = bar; b.x = xb_xcc_id(); b.st = st;
    if (threadIdx.x == 0) st[2] = xb_add(&bar[XB_XCNT(b.x)], 1u);
    return b;
}
__device__ __forceinline__ void xcd_barrier_complete(unsigned* bar, unsigned x, unsigned& nloc, unsigned& nx) {
    const unsigned G = gridDim.x * gridDim.y * gridDim.z;
    unsigned sum, cnt, mine, sp = 0u;
    for (;;) {
        sum = 0u; cnt = 0u; mine = 0u;
#pragma unroll
        for (unsigned j = 0; j < 16; ++j) { const unsigned c = xb_ld(&bar[XB_XCNT(j)]); sum += c; cnt += (c > 0u) ? 1u : 0u; mine = (j == x) ? c : mine; }
        if (sum == G) break;
        __builtin_amdgcn_s_sleep(1);
        if ((++sp & 255u) == 0u) { if (xb_ld(&bar[XB_TMO])) break; if (sp > XB_SPIN_CAP) { atomicAdd(&bar[XB_TMO], 1u); break; } }
    }
    nloc = mine > 0u ? mine : 1u; nx = cnt > 0u ? cnt : 1u;
}

__device__ __forceinline__ void xcd_barrier(const XcdBarrier& b) {
    asm volatile("s_waitcnt vmcnt(0)" ::: "memory");
    __syncthreads();
    if (threadIdx.x == 0) {
        unsigned* bar = b.bar;
        __builtin_amdgcn_s_waitcnt(0);
        unsigned nloc = b.st[0], nx = b.st[1];
        if (nloc == 0u) { xcd_barrier_complete(bar, b.x, nloc, nx); b.st[0] = nloc; b.st[1] = nx; }
        const unsigned old = xb_add(&bar[XB_XSUB(b.x)], 1u);
        const unsigned gen = old / nloc;
        if (old + 1u == (gen + 1u) * nloc) {
            __builtin_amdgcn_fence(__ATOMIC_RELEASE, "agent");
            asm volatile("s_waitcnt vmcnt(0)" ::: "memory");
            const unsigned og = xb_add(&bar[XB_TOP], 1u);
            const unsigned tg = og / nx;
            if (og + 1u == (tg + 1u) * nx) xb_add(&bar[XB_TOPGEN], 1u);
            else XB_SPIN(xb_ld(&bar[XB_TOPGEN]) == tg, bar);
            __builtin_amdgcn_fence(__ATOMIC_ACQUIRE, "agent");
            xb_add(&bar[XB_XGEN(b.x)], 1u);
            asm volatile("s_waitcnt vmcnt(0)" ::: "memory");
        } else {
            XB_SPIN(xb_ld(&bar[XB_XGEN(b.x)]) == gen, bar);
            __builtin_amdgcn_fence(__ATOMIC_ACQUIRE, "agent");
            asm volatile("s_waitcnt vmcnt(0)" ::: "memory");
        }
    }
    __syncthreads();
}

__device__ __forceinline__ void xcd_barrier_local(const XcdBarrier& b) {
    asm volatile("s_waitcnt vmcnt(0)" ::: "memory");
    __syncthreads();
    if (threadIdx.x == 0) {
        unsigned* bar = b.bar;
        __builtin_amdgcn_s_waitcnt(0);
        const unsigned nloc = b.st[0];
        const unsigned old = xb_add(&bar[XB_XSUB(b.x)], 1u);
        const unsigned gen = old / nloc;
        if (old + 1u == (gen + 1u) * nloc) xb_add(&bar[XB_XGEN(b.x)], 1u);
        else XB_SPIN(xb_ld(&bar[XB_XGEN(b.x)]) == gen, bar);
        __builtin_amdgcn_fence(__ATOMIC_ACQUIRE, "agent");
        asm volatile("s_waitcnt vmcnt(0)" ::: "memory");
    }
    __syncthreads();
}


struct Args { const float* in[16]; float* out; unsigned char* ws; int ph_lo, ph_hi; };
#define AS4 __attribute__((address_space(4)))
typedef const unsigned char AS4* kargp_t;
__device__ __forceinline__ kargp_t karg_fresh() { kargp_t p = (kargp_t)__builtin_amdgcn_kernarg_segment_ptr(); asm volatile("" : "+s"(p)); return p; }
template <class T> __device__ __forceinline__ T karg(kargp_t p, int off) { return *(const T AS4*)(p + off); }
#define KIN(p, i) karg<const float*>((p), 8 * (i))
#define KOUT(p) karg<float*>((p), 128)
#define KWS(p) karg<unsigned char*>((p), 136)
static_assert(sizeof(Args) == 152, "Args layout");

__device__ __forceinline__ float wave_sum(float v) {
#pragma unroll
    for (int o = 1; o < 64; o <<= 1) v += __shfl_xor(v, o);
    return v;
}
__device__ __forceinline__ void p0_transpose_item(const float* W, int N, bf16* WT, int ldwt, int coff, LAS float* scr, int kb, int nb, int lane) {
    const int k0 = 64 * kb, n0 = 32 * nb;
#pragma unroll 8
    for (int i = 0; i < 32; ++i) { const int kk = 2 * i + (lane >> 5); scr[kk * 33 + (lane & 31)] = W[(size_t)(k0 + kk) * N + n0 + (lane & 31)]; }
    LDS_WAIT(); asm volatile("" ::: "memory");
    const int c = lane & 7;
#pragma unroll
    for (int j = 0; j < 4; ++j) { const int n = (lane >> 3) + 8 * j; const LAS float* s = scr + (8 * c) * 33 + n;
        v4u o; o.x = cvtpk(s[0 * 33], s[1 * 33]); o.y = cvtpk(s[2 * 33], s[3 * 33]); o.z = cvtpk(s[4 * 33], s[5 * 33]); o.w = cvtpk(s[6 * 33], s[7 * 33]);
        *(v4u*)(WT + (size_t)(n0 + n) * ldwt + coff + k0 + 8 * c) = o; }
    LDS_WAIT(); asm volatile("" ::: "memory");
}

__device__ __forceinline__ void p0_prologue(kargp_t kp, LAS unsigned char* lds, int tid, int lane, int wave, int G) {
    unsigned char* ws = KWS(kp);
    const float *x = KIN(kp, 0), *p = KIN(kp, 1), *g_pre = KIN(kp, 2), *w_in = KIN(kp, 3), *w_pool = KIN(kp, 4), *pool_scale = KIN(kp, 5), *w_out = KIN(kp, 7), *w_ple = KIN(kp, 14);
    bf16 *WinT = (bf16*)(ws + WS_WIN), *WpleT = (bf16*)(ws + WS_WPLE), *WoutT = (bf16*)(ws + WS_WOUT);
    bf16 *XN = (bf16*)(ws + WS_XN), *PB = (bf16*)(ws + WS_PB);
    for (int item = blockIdx.x; item < 128; item += G) {
        const int g = item >> 5, n0 = (item & 31) * 32;
        LAS float* wps = (LAS float*)lds;
        LAS float* wo = (LAS float*)(lds + 128 * 129 * 4);
        for (int i = 0; i < 32; ++i) { const int idx = i * 512 + tid, c = idx >> 7, d = idx & 127; wps[c * 129 + d] = w_pool[(size_t)g * 16384 + idx] * pool_scale[g * 128 + d]; }
        for (int i = 0; i < 8; ++i) { const int idx = i * 512 + tid, d = idx >> 5, nn = idx & 31; wo[idx] = w_out[(size_t)(g * 128 + d) * 1024 + n0 + nn]; }
        __syncthreads();
        const int c = tid & 127, nq = tid >> 7;
        float acc[8];
#pragma unroll
        for (int j = 0; j < 8; ++j) acc[j] = 0.f;
#pragma unroll 4
        for (int d = 0; d < 128; ++d) { const float av = wps[c * 129 + d]; const f32x4 b0 = *(const LAS f32x4*)(wo + d * 32 + nq * 8), b1 = *(const LAS f32x4*)(wo + d * 32 + nq * 8 + 4);
#pragma unroll
            for (int j = 0; j < 4; ++j) { acc[j] += av * b0[j]; acc[4 + j] += av * b1[j]; } }
#pragma unroll
        for (int j = 0; j < 8; ++j) WoutT[(size_t)(n0 + nq * 8 + j) * 1024 + g * 128 + c] = (bf16)(cvtpk(acc[j], 0.f) & 0xffffu);
        __syncthreads();
    }
    LAS float* scr = (LAS float*)(lds + wave * 16384);
    const int gw = blockIdx.x * NWAVES + wave, NGW = G * NWAVES;
    {
        constexpr int I_IN = 16 * 64, I_PLE = 4 * 32, NITEMS = I_IN + I_PLE;
        const int tb0 = (G > 128) ? 128 : 0, tw = (int)blockIdx.x - tb0;
        if (tw >= 0)
        for (int it = tw * NWAVES + wave; it < NITEMS; it += (G - tb0) * NWAVES) {
            int r = it;
            if (r < I_IN) { p0_transpose_item(w_in, 2048, WinT, 1024, 0, scr, r / 64, r % 64, lane); continue; } r -= I_IN;
            p0_transpose_item(w_ple, 1024, WpleT, 256, 0, scr, r / 32, r % 32, lane);
        }
    }
    {
        f32x4 gv[4];
#pragma unroll
        for (int j = 0; j < 4; ++j) gv[j] = *(const f32x4*)(g_pre + 4 * lane + 256 * j);
        for (int m = gw; m < M; m += NGW) {
            const f32x4* xr = (const f32x4*)(x + (size_t)m * D) + lane; f32x4 v[4]; float s = 0.f;
#pragma unroll
            for (int j = 0; j < 4; ++j) { v[j] = xr[64 * j]; s += (v[j].x * v[j].x + v[j].y * v[j].y) + (v[j].z * v[j].z + v[j].w * v[j].w); }
            const float rstd = 1.f / sqrtf(wave_sum(s) * (1.f / D) + EPS);
            v2u* o8 = (v2u*)(XN + (size_t)m * D) + lane;
#pragma unroll
            for (int j = 0; j < 4; ++j) { const f32x4 y = v[j] * rstd * gv[j]; v2u w; w.x = cvtpk(y.x, y.y); w.y = cvtpk(y.z, y.w); o8[64 * j] = w; }
        }
    }
    for (size_t i = (size_t)gw * 64 + lane; i < (size_t)M * PLE / 8; i += (size_t)NGW * 64) {
        const f32x4 a0 = *(const f32x4*)(p + i * 8), a1 = *(const f32x4*)(p + i * 8 + 4);
        v4u w; w.x = cvtpk(a0.x, a0.y); w.y = cvtpk(a0.z, a0.w); w.z = cvtpk(a1.x, a1.y); w.w = cvtpk(a1.z, a1.w);
        *(v4u*)(PB + i * 8) = w;
    }
}

__device__ __forceinline__ void late_weights(kargp_t kp, LAS unsigned char* lds, int lane, int wave, int G) {
    unsigned char* ws = KWS(kp);
    const float *w_out = KIN(kp, 7), *w_up = KIN(kp, 10), *w_down = KIN(kp, 11), *w_gate = KIN(kp, 13);
    bf16 *WoutT = (bf16*)(ws + WS_WOUT), *WupT = (bf16*)(ws + WS_WUP), *WdownT = (bf16*)(ws + WS_WDOWN), *WgateT = (bf16*)(ws + WS_WGATE);
    LAS float* scr = (LAS float*)(lds + wave * 16384);
    const int gw = blockIdx.x * NWAVES + wave, NGW = G * NWAVES;
    constexpr int I_OUT = 8 * 32, I_UP = 16 * 128, I_DOWN = 64 * 32, I_GATE = 16 * 32, NITEMS = I_OUT + I_UP + I_DOWN + I_GATE;
    for (int it = gw; it < NITEMS; it += NGW) {
        int r = it;
        if (r < I_OUT) { p0_transpose_item(w_out + (size_t)512 * 1024, 1024, WoutT, 1024, 512, scr, r / 32, r % 32, lane); continue; } r -= I_OUT;
        if (r < I_UP) { p0_transpose_item(w_up, 4096, WupT, 1024, 0, scr, r / 128, r % 128, lane); continue; } r -= I_UP;
        if (r < I_DOWN) { p0_transpose_item(w_down, 1024, WdownT, 4096, 0, scr, r / 32, r % 32, lane); continue; } r -= I_DOWN;
        p0_transpose_item(w_gate, 1024, WgateT, 1024, 0, scr, r / 32, r % 32, lane);
    }
}

__device__ __forceinline__ void pool_acc(float (&s)[8], const v4u v, const float m) {
    s[0] += m * bflo(v.x); s[1] += m * bfhi(v.x); s[2] += m * bflo(v.y); s[3] += m * bfhi(v.y); s[4] += m * bflo(v.z); s[5] += m * bfhi(v.z); s[6] += m * bflo(v.w); s[7] += m * bfhi(v.w);
}
template <int W> __device__ __forceinline__ void pool_item(const bf16* PROJ, bf16* MIXIN, int m0, int col) {
    const int t0 = m0 & (SEQ - 1);
    const bf16* up = PROJ + (size_t)m0 * LDP + col;
    v4u v[W + 7];
#pragma unroll
    for (int j = 0; j < W + 7; ++j) { const int dr = j - (W - 1); const int drc = (t0 + dr < 0) ? -t0 : dr; v[j] = *(const v4u*)(up + (ptrdiff_t)drc * LDP); }
    float s[8];
#pragma unroll
    for (int e = 0; e < 8; ++e) s[e] = 0.f;
#pragma unroll
    for (int j = 0; j < W - 1; ++j) pool_acc(s, v[j], (t0 + j - (W - 1) >= 0) ? 1.f : 0.f);
#pragma unroll
    for (int i = 0; i < 8; ++i) {
        const v4u c = v[W - 1 + i];
        pool_acc(s, c, 1.f);
        const int n = (t0 + i + 1 < W) ? (t0 + i + 1) : W;
        const float inv = __builtin_amdgcn_rcpf((float)n);
        v4u o; o.x = cvtpk(s[0] * inv - bflo(c.x), s[1] * inv - bfhi(c.x)); o.y = cvtpk(s[2] * inv - bflo(c.y), s[3] * inv - bfhi(c.y));
        o.z = cvtpk(s[4] * inv - bflo(c.z), s[5] * inv - bfhi(c.z)); o.w = cvtpk(s[6] * inv - bflo(c.w), s[7] * inv - bfhi(c.w));
        *(v4u*)(MIXIN + (size_t)(m0 + i) * D + col) = o;
        pool_acc(s, v[i], (t0 + i - (W - 1) >= 0) ? -1.f : 0.f);
    }
}
__device__ __forceinline__ void p2_pool(const bf16* PROJ, bf16* MIXIN, int gtid, int nthreads) {
    for (int item = gtid; item < (M / 8) * 64; item += nthreads) {
        const int cgl = item & 15, rsub = (item >> 4) & 3, g = (item >> 6) & 3, rb = (item >> 8) * 4 + rsub;
        const int col = g * 128 + cgl * 8, m0 = rb * 8;
        if (g == 0) pool_item<2>(PROJ, MIXIN, m0, col); else if (g == 1) pool_item<4>(PROJ, MIXIN, m0, col); else if (g == 2) pool_item<8>(PROJ, MIXIN, m0, col); else pool_item<16>(PROJ, MIXIN, m0, col);
    }
}

#define MFMA32(a, b, c) __builtin_amdgcn_mfma_f32_32x32x16_bf16((a), (b), (c), 0, 0, 0)
__device__ __forceinline__ void sb_load_tile(bf16x8 (&kf)[4], s16x4 (&vf)[2][2][2], const bf16* kp, const bf16* vp) {
#pragma unroll
    for (int ks = 0; ks < 4; ++ks) kf[ks] = *(const bf16x8*)(kp + 16 * ks);
#pragma unroll
    for (int db = 0; db < 2; ++db)
#pragma unroll
        for (int s = 0; s < 2; ++s)
#pragma unroll
            for (int hf = 0; hf < 2; ++hf) vf[db][s][hf] = *(const s16x4*)(vp + ((4 * s + 2 * hf) * 64 + 32 * db) * 4);
}
__device__ __forceinline__ void sb_unit(const bf16* PROJ, const bf16* VT, const float* g_sb, bf16* MIXIN, int b, int h, int qb, int lane) {
    const int r = lane & 31, hi = lane >> 5, t0 = qb * 32;
    const size_t mrow0 = (size_t)b * SEQ + t0;
    bf16x8 qf[4];
    { const bf16* qp = PROJ + (mrow0 + r) * LDP + 512 + h * HD + 8 * hi;
#pragma unroll
      for (int ks = 0; ks < 4; ++ks) qf[ks] = *(const bf16x8*)(qp + 16 * ks); }
    f32x16 o0, o1;
#pragma unroll
    for (int i = 0; i < 16; ++i) { o0[i] = 0.f; o1[i] = 0.f; }
    float carry = 1.f;
    const bf16* kbase = PROJ + ((size_t)b * SEQ + r) * LDP + 1024 + h * HD + 8 * hi;
    const bf16* vbase = VT + ((size_t)(b * NH + h) * (SEQ / 4) + hi) * 256 + r * 4;
    bf16x8 kf[4], kn[4]; s16x4 vf[2][2][2], vn[2][2][2];
    sb_load_tile(kf, vf, kbase + (size_t)t0 * LDP, vbase + (size_t)t0 * 64);
    for (int kt = t0; kt >= 0; kt -= 32) {
        const bool more = kt >= 32;
        if (more) sb_load_tile(kn, vn, kbase + (size_t)(kt - 32) * LDP, vbase + (size_t)(kt - 32) * 64);
        f32x16 s;
#pragma unroll
        for (int i = 0; i < 16; ++i) s[i] = 0.f;
#pragma unroll
        for (int ks = 0; ks < 4; ++ks) s = MFMA32(kf[ks], qf[ks], s);
        const bool diag = (kt == t0);
        float f[16], gp[4], pp[4], a[16];
#pragma unroll
        for (int i = 0; i < 16; ++i) {
            const int kr = (i & 3) + 8 * (i >> 2) + 4 * hi;
            const float e = __builtin_amdgcn_exp2f(s[i] * (0.125f * 1.4426950408889634f));
            const float fi = __builtin_amdgcn_rcpf(1.f + e);
            f[i] = (!diag || (kr < r)) ? fi : 1.f;
        }
#pragma unroll
        for (int g4 = 0; g4 < 4; ++g4) gp[g4] = (f[4 * g4] * f[4 * g4 + 1]) * (f[4 * g4 + 2] * f[4 * g4 + 3]);
#pragma unroll
        for (int g4 = 0; g4 < 4; ++g4) pp[g4] = __shfl_xor(gp[g4], 32);
        float base = carry;
#pragma unroll
        for (int g4 = 3; g4 >= 0; --g4) {
            float run = (hi == 0) ? base * pp[g4] : base;
#pragma unroll
            for (int e = 3; e >= 0; --e) { const int i = 4 * g4 + e; const float nxt = run * f[i]; a[i] = run - nxt; run = nxt; }
            base *= gp[g4] * pp[g4];
        }
        carry = base;
        bf16x8 a0, a1;
        { v4u w0, w1; w0.x = cvtpk(a[0], a[1]); w0.y = cvtpk(a[2], a[3]); w0.z = cvtpk(a[4], a[5]); w0.w = cvtpk(a[6], a[7]);
          w1.x = cvtpk(a[8], a[9]); w1.y = cvtpk(a[10], a[11]); w1.z = cvtpk(a[12], a[13]); w1.w = cvtpk(a[14], a[15]);
          a0 = __builtin_bit_cast(bf16x8, w0); a1 = __builtin_bit_cast(bf16x8, w1); }
        {
            const bf16x8 v00 = __builtin_shufflevector(vf[0][0][0], vf[0][0][1], 0, 1, 2, 3, 4, 5, 6, 7), v01 = __builtin_shufflevector(vf[0][1][0], vf[0][1][1], 0, 1, 2, 3, 4, 5, 6, 7);
            const bf16x8 v10 = __builtin_shufflevector(vf[1][0][0], vf[1][0][1], 0, 1, 2, 3, 4, 5, 6, 7), v11 = __builtin_shufflevector(vf[1][1][0], vf[1][1][1], 0, 1, 2, 3, 4, 5, 6, 7);
            o0 = MFMA32(v00, a0, o0); o0 = MFMA32(v01, a1, o0);
            o1 = MFMA32(v10, a0, o1); o1 = MFMA32(v11, a1, o1);
        }
        if (__all(carry < 1e-37f)) break;
        if (more) {
#pragma unroll
            for (int ks = 0; ks < 4; ++ks) kf[ks] = kn[ks];
#pragma unroll
            for (int db = 0; db < 2; ++db)
#pragma unroll
                for (int s2 = 0; s2 < 2; ++s2)
#pragma unroll
                    for (int hf = 0; hf < 2; ++hf) vf[db][s2][hf] = vn[db][s2][hf];
        }
    }
    float ss = 0.f;
#pragma unroll
    for (int i = 0; i < 16; ++i) ss += o0[i] * o0[i] + o1[i] * o1[i];
    ss += __shfl_xor(ss, 32);
    const float rstd = 1.f / sqrtf(ss * (1.f / HD) + EPS);
    bf16* op = MIXIN + (mrow0 + r) * D + 512 + h * HD + 4 * hi;
    const float* gp = g_sb + h * HD + 4 * hi;
#pragma unroll
    for (int g4 = 0; g4 < 4; ++g4) {
        const f32x4 ga = *(const f32x4*)(gp + 8 * g4), gb = *(const f32x4*)(gp + 32 + 8 * g4);
        v2u wa, wb;
        wa.x = cvtpk(o0[4 * g4] * rstd * ga.x, o0[4 * g4 + 1] * rstd * ga.y); wa.y = cvtpk(o0[4 * g4 + 2] * rstd * ga.z, o0[4 * g4 + 3] * rstd * ga.w);
        wb.x = cvtpk(o1[4 * g4] * rstd * gb.x, o1[4 * g4 + 1] * rstd * gb.y); wb.y = cvtpk(o1[4 * g4 + 2] * rstd * gb.z, o1[4 * g4 + 3] * rstd * gb.w);
        *(v2u*)(op + 8 * g4) = wa; *(v2u*)(op + 32 + 8 * g4) = wb;
    }
}

__device__ __forceinline__ void p4_rows(const float* x, const bf16* MIX, const float* SS, const float* g_post, const float* g_pre2, float* out, bf16* XN, int mfirst, int mend, int mstep, int lane) {
    f32x4 gp[4], gq[4];
#pragma unroll
    for (int j = 0; j < 4; ++j) { gp[j] = *(const f32x4*)(g_post + 4 * lane + 256 * j); gq[j] = *(const f32x4*)(g_pre2 + 4 * lane + 256 * j); }
    for (int m = mfirst; m < mend; m += mstep) {
        const f32x4* sp = (const f32x4*)(SS + (size_t)m * 16); const f32x4 s0 = sp[0], s1 = sp[1], s2 = sp[2], s3 = sp[3];
        const float tot = ((s0.x + s0.y) + (s0.z + s0.w)) + ((s1.x + s1.y) + (s1.z + s1.w)) + ((s2.x + s2.y) + (s2.z + s2.w)) + ((s3.x + s3.y) + (s3.z + s3.w));
        const float r1 = 1.f / sqrtf(tot * (1.f / D) + EPS);
        const f32x4* xr = (const f32x4*)(x + (size_t)m * D) + lane; const v2u* mr = (const v2u*)(MIX + (size_t)m * D) + lane;
        f32x4 hv[4]; float q = 0.f;
#pragma unroll
        for (int j = 0; j < 4; ++j) { const f32x4 xv = xr[64 * j]; const v2u mw = mr[64 * j]; const f32x4 mv = {bflo(mw.x), bfhi(mw.x), bflo(mw.y), bfhi(mw.y)};
            hv[j] = xv + mv * r1 * gp[j]; q += (hv[j].x * hv[j].x + hv[j].y * hv[j].y) + (hv[j].z * hv[j].z + hv[j].w * hv[j].w); }
        const float r2 = 1.f / sqrtf(wave_sum(q) * (1.f / D) + EPS);
        v2u* orow = (v2u*)(out + (size_t)m * D) + lane; v2u* nrow = (v2u*)(XN + (size_t)m * D) + lane;
#pragma unroll
        for (int j = 0; j < 4; ++j) { v2u hw; hw.x = cvtpk(hv[j].x, hv[j].y); hw.y = cvtpk(hv[j].z, hv[j].w); orow[64 * j] = hw;
            const f32x4 y = hv[j] * r2 * gq[j]; v2u w; w.x = cvtpk(y.x, y.y); w.y = cvtpk(y.z, y.w); nrow[64 * j] = w; }
    }
}
__device__ __forceinline__ void p7_rows(const bf16* MIX, const float* SS, const float* SSE, const float* g_post, const float* h1, bf16* XN, float* RSTDE, float* RSTD2, int mfirst, int mend, int mstep, int lane) {
    f32x4 gp[4];
#pragma unroll
    for (int j = 0; j < 4; ++j) gp[j] = *(const f32x4*)(g_post + 4 * lane + 256 * j);
    for (int m = mfirst; m < mend; m += mstep) {
        const f32x4* sp = (const f32x4*)(SS + (size_t)m * 16); const f32x4 s0 = sp[0], s1 = sp[1], s2 = sp[2], s3 = sp[3];
        const float tot = ((s0.x + s0.y) + (s0.z + s0.w)) + ((s1.x + s1.y) + (s1.z + s1.w)) + ((s2.x + s2.y) + (s2.z + s2.w)) + ((s3.x + s3.y) + (s3.z + s3.w));
        const float r1 = 1.f / sqrtf(tot * (1.f / D) + EPS);
        const f32x4* ep = (const f32x4*)(SSE + (size_t)m * 16); const f32x4 e0 = ep[0], e1 = ep[1], e2 = ep[2], e3 = ep[3];
        const float te = ((e0.x + e0.y) + (e0.z + e0.w)) + ((e1.x + e1.y) + (e1.z + e1.w)) + ((e2.x + e2.y) + (e2.z + e2.w)) + ((e3.x + e3.y) + (e3.z + e3.w));
        if (lane == 0) RSTDE[m] = 1.f / sqrtf(te * (1.f / D) + EPS);
        const v2u* irow = (const v2u*)(h1 + (size_t)m * D) + lane; const v2u* mr = (const v2u*)(MIX + (size_t)m * D) + lane; v2u* nrow = (v2u*)(XN + (size_t)m * D) + lane;
#pragma unroll
        for (int j = 0; j < 4; ++j) { const v2u hw = irow[64 * j]; const f32x4 hv0 = {bflo(hw.x), bfhi(hw.x), bflo(hw.y), bfhi(hw.y)}; const v2u mw = mr[64 * j]; const f32x4 mv = {bflo(mw.x), bfhi(mw.x), bflo(mw.y), bfhi(mw.y)};
            const f32x4 hv = hv0 + mv * r1 * gp[j]; v2u w; w.x = cvtpk(hv.x, hv.y); w.y = cvtpk(hv.z, hv.w); nrow[64 * j] = w; }
    }
}

__global__ void __launch_bounds__(NWAVES * 64, 2) fwd_megakernel(Args args) {
    extern __shared__ __attribute__((aligned(16))) unsigned char lds_raw[];
    LAS unsigned char* lds = (LAS unsigned char*)lds_raw;
    const int tid = threadIdx.x, lane = tid & 63, wave = __builtin_amdgcn_readfirstlane(tid >> 6);
    volatile LAS unsigned* MISC = (volatile LAS unsigned*)(lds + MISC_OFF);
    if (tid < 32) MISC[tid] = 0u;
    __syncthreads();
    { kargp_t kp = karg_fresh(); (void)xcd_barrier_post((unsigned*)(KWS(kp) + WS_CTL), MISC + 8);
      if (karg<int>(kp, 148) > 1000) cg::this_grid().sync(); }
#define MKBAR() XcdBarrier bar; bar.bar = (unsigned*)(KWS(karg_fresh()) + WS_CTL); bar.x = xb_xcc_id(); bar.st = MISC + 8
#define SEAM() do { MKBAR(); xcd_barrier(bar); } while (0)
#define SEAML() do { MKBAR(); if (__builtin_amdgcn_readfirstlane((int)MISC[11]) != 0) xcd_barrier_local(bar); else xcd_barrier(bar); } while (0)
#define CDEAL() ((__builtin_amdgcn_readfirstlane((int)MISC[11]) != 0) ? __builtin_amdgcn_readfirstlane((int)MISC[12]) : (int)blockIdx.x)

    { kargp_t kp = karg_fresh(); p0_prologue(kp, lds, tid, lane, wave, (int)gridDim.x); }
    SEAM();
    {
        if (tid == 0) { unsigned* bw = (unsigned*)(KWS(karg_fresh()) + WS_CTL); unsigned ok = (gridDim.x == 256) ? 1u : 0u;
            for (unsigned j = 0; j < 16; ++j) { const unsigned c = xb_ld(&bw[XB_XCNT(j)]); ok &= (j < 8) ? (c == 32u ? 1u : 0u) : (c == 0u ? 1u : 0u); }
            MISC[12] = MISC[10] * 8u + xb_xcc_id(); MISC[11] = ok; }
        __syncthreads();
    }
    {
        kargp_t kp = karg_fresh(); unsigned char* ws = KWS(kp); const int G = (int)gridDim.x;
        bf16 *WinT = (bf16*)(ws + WS_WIN), *WpleT = (bf16*)(ws + WS_WPLE), *XN = (bf16*)(ws + WS_XN), *PB = (bf16*)(ws + WS_PB), *PROJ = (bf16*)(ws + WS_PROJ), *VT = (bf16*)(ws + WS_VT), *ERAW = (bf16*)(ws + WS_ERAW);
        float* SSE = (float*)(ws + WS_SSE);
        const bool eraw_first = ((blockIdx.x >> 3) & 1) != 0;
        if (eraw_first) {
            pg8::Gemm g{PB, WpleT, M, D, PLE}; pg8::StaticOrder S; S.init(M, D, G, (int)blockIdx.x);
            pg8::EpiStore<0, true> E{ERAW, D, SSE};
            pg8::gemm_phase<pg8::EpiStore<0, true>, pg8::StaticOrder, PG8_ALIGN, PG8_SP2>(lds, g, S, E);
        }
        {
            pg8::Gemm g{XN, WinT, M, LDP, D}; pg8::StaticOrder S; S.init(M, LDP, G, (int)blockIdx.x);
            pg8::EpiStore<0, false> E{PROJ, LDP, nullptr};
            pg8::gemm_phase<pg8::EpiStore<0, false>, pg8::StaticOrder, PG8_ALIGN, PG8_SP2>(lds, g, S, E);
        }
        {
            pg8::Gemm g{WinT + (size_t)1536 * D, XN, 512, M, D}; pg8::StaticOrder S; S.init(512, M, G, (int)((blockIdx.x + G / 2) % G));
            pg8::EpiVT4 E{VT};
            pg8::gemm_phase<pg8::EpiVT4, pg8::StaticOrder, PG8_ALIGN, PG8_SP2>(lds, g, S, E);
        }
        if (!eraw_first) {
            pg8::Gemm g{PB, WpleT, M, D, PLE}; pg8::StaticOrder S; S.init(M, D, G, (int)blockIdx.x);
            pg8::EpiStore<0, true> E{ERAW, D, SSE};
            pg8::gemm_phase<pg8::EpiStore<0, true>, pg8::StaticOrder, PG8_ALIGN, PG8_SP2>(lds, g, S, E);
        }
    }
    SEAM();
    {
        kargp_t kp = karg_fresh(); unsigned char* ws = KWS(kp); const int G = (int)gridDim.x;
        const bf16 *PROJ = (const bf16*)(ws + WS_PROJ), *VT = (const bf16*)(ws + WS_VT); bf16* MIXIN = (bf16*)(ws + WS_MIXIN);
        p2_pool(PROJ, MIXIN, blockIdx.x * 512 + tid, G * 512);
        const float* g_sb = KIN(kp, 6);
        constexpr int NU = BATCH * NH * (SEQ / 32); const int upw = (NU + G - 1) / G, ubeg = blockIdx.x * upw, uend = (ubeg + upw < NU) ? ubeg + upw : NU;
        if (wave >= 4) late_weights(kp, lds, lane, wave, G);
        for (int u = ubeg + wave; u < uend; u += NWAVES) { const int qb = u & 255, bh = u >> 8, h = bh & 7, b = bh >> 3; sb_unit(PROJ, VT, g_sb, MIXIN, b, h, qb, lane); }
        if (wave < 4) late_weights(kp, lds, lane, wave, G);
    }
    SEAM();
    {
        kargp_t kp = karg_fresh(); unsigned char* ws = KWS(kp);
        pg8::Gemm g{(const bf16*)(ws + WS_MIXIN), (const bf16*)(ws + WS_WOUT), M, D, D}; pg8::StaticOrder S; S.init(M, D, (int)gridDim.x, CDEAL());
        pg8::EpiStore<0, true> E{(bf16*)(ws + WS_MIX), D, (float*)(ws + WS_SS1)};
        pg8::gemm_phase<pg8::EpiStore<0, true>, pg8::StaticOrder, PG8_ALIGN, PG8_SP2>(lds, g, S, E);
    }
    SEAML();
    {
        kargp_t kp = karg_fresh(); unsigned char* ws = KWS(kp);
        const bool fast = __builtin_amdgcn_readfirstlane((int)MISC[11]) != 0; const int cd = CDEAL(), xcc = cd & 7;
        const int rfirst = fast ? 2048 * xcc + (cd >> 3) * NWAVES + wave : (int)blockIdx.x * NWAVES + wave, rend = fast ? 2048 * (xcc + 1) : M, rstep = fast ? 256 : (int)gridDim.x * NWAVES;
        p4_rows(KIN(kp, 0), (const bf16*)(ws + WS_MIX), (const float*)(ws + WS_SS1), KIN(kp, 8), KIN(kp, 9), KOUT(kp), (bf16*)(ws + WS_XN), rfirst, rend, rstep, lane);
    }
    SEAML();
    {
        kargp_t kp = karg_fresh(); unsigned char* ws = KWS(kp);
        pg8::Gemm g{(const bf16*)(ws + WS_XN), (const bf16*)(ws + WS_WUP), M, FF, D}; pg8::StaticOrder S; S.init(M, FF, (int)gridDim.x, CDEAL());
        pg8::EpiStore<1, false> E{(bf16*)(ws + WS_A), FF, nullptr};
        pg8::gemm_phase<pg8::EpiStore<1, false>, pg8::StaticOrder, PG8_ALIGN, PG8_SP2>(lds, g, S, E);
    }
    SEAML();
    {
        kargp_t kp = karg_fresh(); unsigned char* ws = KWS(kp);
        pg8::Gemm g{(const bf16*)(ws + WS_A), (const bf16*)(ws + WS_WDOWN), M, D, FF}; pg8::StaticOrder S; S.init(M, D, (int)gridDim.x, CDEAL());
        pg8::EpiStore<0, true> E{(bf16*)(ws + WS_MIX), D, (float*)(ws + WS_SS2)};
        pg8::gemm_phase<pg8::EpiStore<0, true>, pg8::StaticOrder, PG8_ALIGN, PG8_SP2>(lds, g, S, E);
    }
    SEAML();
    {
        kargp_t kp = karg_fresh(); unsigned char* ws = KWS(kp);
        const bool fast = __builtin_amdgcn_readfirstlane((int)MISC[11]) != 0; const int cd = CDEAL(), xcc = cd & 7;
        const int rfirst = fast ? 2048 * xcc + (cd >> 3) * NWAVES + wave : (int)blockIdx.x * NWAVES + wave, rend = fast ? 2048 * (xcc + 1) : M, rstep = fast ? 256 : (int)gridDim.x * NWAVES;
        p7_rows((const bf16*)(ws + WS_MIX), (const float*)(ws + WS_SS2), (const float*)(ws + WS_SSE), KIN(kp, 12), KOUT(kp), (bf16*)(ws + WS_XN), (float*)(ws + WS_RSTDE), (float*)(ws + WS_RSTDE) + M, rfirst, rend, rstep, lane);
    }
    SEAML();
    {
        kargp_t kp = karg_fresh(); unsigned char* ws = KWS(kp);
        pg8::Gemm g{(const bf16*)(ws + WS_XN), (const bf16*)(ws + WS_WGATE), M, D, D}; pg8::StaticOrder S; S.init(M, D, (int)gridDim.x, CDEAL());
        pg8::EpiFinal E{KOUT(kp), (const bf16*)(ws + WS_XN), (const bf16*)(ws + WS_ERAW), (const float*)(ws + WS_RSTDE), KIN(kp, 15)};
        pg8::gemm_phase<pg8::EpiFinal, pg8::StaticOrder, PG8_ALIGN, PG8_SP2>(lds, g, S, E);
    }
#undef MKBAR
#undef SEAM
#undef SEAML
#undef CDEAL
}

extern "C" void kernel_launch(void* const* d_in, const int* in_sizes, int n_in, void* d_out, int out_size, void* d_ws, size_t ws_size, hipStream_t stream) {
    static int grid = 0;
    if (grid == 0) {
        if (n_in != 16 || in_sizes[0] != M * D || out_size != M * D || ws_size < WS_END) { fprintf(stderr, "kernel_launch: unexpected shapes (n_in %d, in0 %d, out %d, ws %zu)\n", n_in, n_in > 0 ? in_sizes[0] : -1, out_size, ws_size); grid = -1; return; }
        int dev = 0, cus = 0, per_cu = 0;
        if (hipGetDevice(&dev) != hipSuccess || hipDeviceGetAttribute(&cus, hipDeviceAttributeMultiprocessorCount, dev) != hipSuccess) { grid = -1; return; }
        if (hipFuncSetAttribute((const void*)fwd_megakernel, hipFuncAttributeMaxDynamicSharedMemorySize, LDS_BYTES) != hipSuccess) { fprintf(stderr, "kernel_launch: hipFuncSetAttribute failed\n"); grid = -1; return; }
        if (hipOccupancyMaxActiveBlocksPerMultiprocessor(&per_cu, (const void*)fwd_megakernel, NWAVES * 64, LDS_BYTES) != hipSuccess || per_cu < 1) { fprintf(stderr, "kernel_launch: occupancy query says %d\n", per_cu); per_cu = 1; }
        (void)hipGetLastError();
        grid = cus * per_cu;
    }
    if (grid < 0) return;
    if (hipMemsetAsync((char*)d_ws + WS_CTL, 0, CTL_ZERO_BYTES, stream) != hipSuccess) { fprintf(stderr, "kernel_launch: memset failed\n"); return; }
    Args a{};
    for (int i = 0; i < 16; ++i) a.in[i] = (const float*)d_in[i];
    a.out = (float*)d_out; a.ws = (unsigned char*)d_ws;
    a.ph_lo = 0; a.ph_hi = N_PHASES;
    void* kargs[] = {&a};
    hipError_t e = hipLaunchCooperativeKernel((const void*)fwd_megakernel, dim3(grid), dim3(NWAVES * 64), kargs, LDS_BYTES, stream);
    if (e != hipSuccess) fprintf(stderr, "cooperative launch failed: %s (grid %d)\n", hipGetErrorString(e), grid);
}
```
